# Optimizing an MI355X kernel written in HIP

```python
import jax, jax.numpy as jnp
from jax import lax
import numpy as np

D_MODEL = 1024
BATCH = 4
SEQ = 8192
DEPTH = 1

N_META = 16
BLOCK = 128
PAD = BLOCK - N_META
EPS = 1e-6
R_HEADS = 8
R_DK = 128
R_DV = 128
R_QK = R_HEADS * R_DK
R_WIDTH = R_HEADS * R_DV
CHUNK = 64
A_HEADS = 8
A_KV_HEADS = 2
A_HEAD_DIM = 128
A_GROUP = A_HEADS // A_KV_HEADS
A_WIDTH = A_HEADS * A_HEAD_DIM
A_KV = A_KV_HEADS * A_HEAD_DIM
TOPK_MAX = 256
I_HEADS = 8
I_DIM = 64
SPLIT_SIZES = (R_QK, R_QK, R_WIDTH, R_WIDTH,
               A_WIDTH, A_KV, A_KV, A_WIDTH,
               I_HEADS * I_DIM, I_DIM, I_HEADS,
               D_MODEL, D_MODEL)
D_IN = sum(SPLIT_SIZES)

kernel_name = "hybrid_hgrn2_dsa_gated_merge"


def _split_points():
    pts, acc = [], 0
    for s in SPLIT_SIZES[:-1]:
        acc += s
        pts.append(acc)
    return pts


def rmsnorm(x, g):
    xf = x.astype(jnp.float32)
    y = xf * lax.rsqrt(jnp.mean(xf * xf, axis=-1, keepdims=True) + EPS)
    return (y * g.astype(jnp.float32)).astype(x.dtype)


def alibi_slopes(n):
    return 2.0 ** (-8.0 * jnp.arange(1, n + 1, dtype=jnp.float32) / n)


def hgrn2_branch(q, f_logit, inp, lb, valid):
    B, T, _ = q.shape
    lbf = lb.astype(jnp.float32)
    f = lbf + (1.0 - lbf) * jax.nn.sigmoid(f_logit.astype(jnp.float32))
    vm = valid[None, :, None]
    lf = jnp.where(vm, jnp.log(f), 0.0)
    k = jnp.where(vm, 1.0 - f, 0.0)
    qf = jax.nn.silu(q.astype(jnp.float32)) * (R_DK ** -0.5)
    v = inp.astype(jnp.float32)
    nc = T // CHUNK

    def chunks(a, d):
        return a.reshape(B, nc, CHUNK, R_HEADS, d).transpose(1, 0, 3, 2, 4)

    causal = jnp.tril(jnp.ones((CHUNK, CHUNK), bool))

    def step(S, xs):
        qc, kc, vc, lfc = xs
        b = jnp.cumsum(lfc, axis=2)
        o_inter = jnp.einsum('bhtk,bhkv->bhtv', qc * jnp.exp(b), S)
        diff = b[:, :, :, None, :] - b[:, :, None, :, :]
        dec = jnp.exp(jnp.where(causal[:, :, None], diff, -jnp.inf))
        att = jnp.einsum('bhtk,bhsk,bhtsk->bhts', qc, kc, dec)
        o = o_inter + jnp.einsum('bhts,bhsv->bhtv', att, vc)
        b_last = b[:, :, -1:, :]
        S = jnp.exp(b_last[:, :, 0, :])[..., None] * S + jnp.einsum(
            'bhsk,bhsv->bhkv', kc * jnp.exp(b_last - b), vc)
        return S, o

    S0 = jnp.zeros((B, R_HEADS, R_DK, R_DV), jnp.float32)
    _, o = lax.scan(step, S0, (chunks(qf, R_DK), chunks(k, R_DK), chunks(v, R_DV), chunks(lf, R_DK)))
    return o.transpose(1, 0, 3, 2, 4).reshape(B, T, R_HEADS, R_DV).astype(q.dtype)


def dsa_branch(q, k, v, iq, ik, iw, gq, gk, pos, valid, topk):
    B, T, _ = q.shape
    q = rmsnorm(q.reshape(B, T, A_HEADS, A_HEAD_DIM), gq)
    k = rmsnorm(k.reshape(B, T, A_KV_HEADS, A_HEAD_DIM), gk)
    v = v.reshape(B, T, A_KV_HEADS, A_HEAD_DIM)
    iq = iq.reshape(B, T, I_HEADS, I_DIM)
    iw = iw.astype(jnp.float32) * (I_HEADS ** -0.5) * (I_DIM ** -0.5)
    slopes = alibi_slopes(A_HEADS).reshape(A_KV_HEADS, A_GROUP)
    scale = A_HEAD_DIM ** -0.5
    bi = jnp.arange(B)[:, None, None]
    qi = jnp.arange(BLOCK)[None, :, None]

    def one_block(start):
        qb = lax.dynamic_slice_in_dim(q, start, BLOCK, axis=1)
        iqb = lax.dynamic_slice_in_dim(iq, start, BLOCK, axis=1)
        iwb = lax.dynamic_slice_in_dim(iw, start, BLOCK, axis=1)
        qpos = lax.dynamic_slice_in_dim(pos, start, BLOCK)
        admiss = (pos[None, :] <= qpos[:, None]) & valid[None, :]
        logits = jnp.einsum('bqhd,bsd->bqhs', iqb, ik).astype(jnp.float32)
        score = jnp.einsum('bqhs,bqh->bqs', jax.nn.relu(logits), iwb)
        score = jnp.where(admiss[None], score, -jnp.inf)
        _, idx = lax.top_k(score, topk)
        sel_ok = admiss[qi, idx]
        kg = k[bi, idx]
        vg = v[bi, idx]
        qg = qb.reshape(B, BLOCK, A_KV_HEADS, A_GROUP, A_HEAD_DIM)
        s = jnp.einsum('bqhgd,bqkhd->bqhgk', qg, kg).astype(jnp.float32) * scale
        dist = (qpos[None, :, None] - pos[idx]).astype(jnp.float32)
        s = s - slopes[None, None, :, :, None] * dist[:, :, None, None, :]
        s = jnp.where(sel_ok[:, :, None, None, :], s, -1e30)
        p = jax.nn.softmax(s, axis=-1).astype(vg.dtype)
        o = jnp.einsum('bqhgk,bqkhd->bqhgd', p, vg)
        return o.reshape(B, BLOCK, A_WIDTH)

    starts = jnp.arange(T // BLOCK, dtype=jnp.int32) * BLOCK
    out = lax.map(one_block, starts)
    return out.transpose(1, 0, 2, 3).reshape(B, T, A_WIDTH)


def setup_inputs(seed: int = 0) -> dict:
    key = jax.random.key(seed)
    ks = jax.random.split(key, 12)
    f32 = jnp.float32
    return {
        "x": jax.random.normal(ks[0], (BATCH, SEQ, D_MODEL), f32),
        "meta": jax.random.normal(ks[1], (N_META, D_MODEL), f32),
        "norm_g": 1.0 + 0.01 * jax.random.normal(ks[2], (DEPTH, D_MODEL), f32),
        "w_in": jax.random.normal(ks[3], (DEPTH, D_MODEL, D_IN), f32) * D_MODEL ** -0.5,
        "lb_logits": 0.1 * jax.random.normal(ks[4], (DEPTH + 1, R_QK), f32),
        "r_norm_g": 1.0 + 0.01 * jax.random.normal(ks[5], (DEPTH, R_DV), f32),
        "q_norm_g": 1.0 + 0.01 * jax.random.normal(ks[6], (DEPTH, A_HEAD_DIM), f32),
        "k_norm_g": 1.0 + 0.01 * jax.random.normal(ks[7], (DEPTH, A_HEAD_DIM), f32),
        "w_r": jax.random.normal(ks[8], (DEPTH, R_WIDTH, D_MODEL), f32) * R_WIDTH ** -0.5,
        "w_a": jax.random.normal(ks[9], (DEPTH, A_WIDTH, D_MODEL), f32) * A_WIDTH ** -0.5,
        "w_out": jax.random.normal(ks[10], (DEPTH, D_MODEL, D_MODEL), f32) * D_MODEL ** -0.5,
    }


def reference(x, meta, norm_g, w_in, lb_logits, r_norm_g, q_norm_g, k_norm_g, w_r, w_a, w_out):
    B, S, D = x.shape
    topk = min(TOPK_MAX, S // 4)
    T = S + BLOCK
    h = jnp.concatenate([
        jnp.zeros((B, PAD, D), x.dtype),
        jnp.broadcast_to(meta[None].astype(x.dtype), (B, N_META, D)),
        x], axis=1)
    pos = jnp.arange(T, dtype=jnp.int32) - PAD
    valid = pos >= 0
    lb_all = jnp.cumsum(jax.nn.softmax(lb_logits.astype(jnp.float32), axis=0), axis=0)
    pts = _split_points()
    for l in range(DEPTH):
        u = rmsnorm(h, norm_g[l])
        z = u @ w_in[l]
        (r_q, r_f, r_i, r_gate, a_q, a_k, a_v, a_gate,
         i_q, i_k, i_w, m_r, m_a) = jnp.split(z, pts, axis=-1)
        o_r = hgrn2_branch(r_q, r_f, r_i, lb_all[l], valid)
        o_r = rmsnorm(o_r, r_norm_g[l]).reshape(B, T, R_WIDTH)
        y_r = (o_r * jax.nn.silu(r_gate)) @ w_r[l]
        o_a = dsa_branch(a_q, a_k, a_v, i_q, i_k, i_w, q_norm_g[l], k_norm_g[l], pos, valid, topk)
        y_a = (o_a * jax.nn.silu(a_gate)) @ w_a[l]
        merged = jax.nn.sigmoid(m_r) * y_r + jax.nn.sigmoid(m_a) * y_a
        h = h + merged @ w_out[l]
    return h[:, BLOCK:, :]
```

```cpp
#include <hip/hip_runtime.h>
#include <cstdio>
#include <cstdint>

#define GAS __attribute__((address_space(1)))
#define LAS __attribute__((address_space(3)))
#define PG8_LAS __attribute__((address_space(3)))
typedef unsigned short bf16_t;
typedef short bf16x8 __attribute__((ext_vector_type(8)));
typedef short s16x4 __attribute__((ext_vector_type(4)));
typedef float f32x4 __attribute__((ext_vector_type(4)));
typedef float f32x2 __attribute__((ext_vector_type(2)));
typedef unsigned u32x4 __attribute__((ext_vector_type(4)));
typedef unsigned u32x2 __attribute__((ext_vector_type(2)));
typedef GAS unsigned gu32;
typedef GAS unsigned long long gu64;
#define RLX_AGENT __ATOMIC_RELAXED, __HIP_MEMORY_SCOPE_AGENT

constexpr int NB = 4, SEQ = 8192, DM = 1024, NTOK = NB * SEQ;
constexpr int MROWS = NTOK + 256;
constexpr int META_ROW0 = NTOK + 48;
constexpr int NKEY = SEQ + 16;
constexpr int IKC_SUBS = (NKEY + 31) / 32;
constexpr int N1A = 5376, N1B = 4096;
constexpr float EPS = 1e-6f;
constexpr float LOG2E = 1.4426950408889634f;
constexpr int C_RQ = 0, C_RF = 1024, C_RI = 2048, C_RG = 3072, C_AQ = 4096, C_AK = 5120, C_AV = 5376, C_AG = 5632, C_IQ = 6656, C_IK = 7168, C_IW = 7232, C_MR = 7240, C_MA = 8264, D_IN = 9288;

constexpr size_t MiB = 1u << 20;
constexpr size_t WS_CTL = 0, CTL_ZERO_BYTES = 1 * MiB;
constexpr size_t WS_W1A8 = 1 * MiB, WS_W1AI = 6 * MiB, WS_W1B8 = 8 * MiB, WS_WR8 = 12 * MiB, WS_WA8 = 13 * MiB, WS_WO8 = 14 * MiB, WS_LB = 26 * MiB;
constexpr size_t WS_IW = 27 * MiB, WS_IKC = 29 * MiB, WS_XN = 34 * MiB, WS_RQ = 99 * MiB, WS_RF = 164 * MiB, WS_RV = 229 * MiB, WS_AQ = 294 * MiB;
constexpr size_t WS_AK = 359 * MiB, WS_AV = 376 * MiB, WS_IQ = 393 * MiB, WS_KN = 426 * MiB, WS_VV = 435 * MiB, WS_SLOC = 444 * MiB, WS_DSEG = 460 * MiB;
constexpr size_t WS_IDX = 461 * MiB, WS_CNT = 477 * MiB, WS_XN8 = 478 * MiB, WS_END = 511 * MiB;
constexpr size_t WS_GR8 = WS_XN, WS_GA8 = WS_XN + 32 * MiB;
constexpr int N1A8 = 4608, N1AI = 768;
constexpr float WSCALE = 32.f, ZSCALE = 1.f / 32.f;
static_assert((size_t)MROWS * 1024 * 2 <= 65 * MiB && (size_t)MROWS * 512 * 2 <= 33 * MiB && (size_t)MROWS * 256 * 2 <= 17 * MiB, "ws map");
static_assert((size_t)NB * 2 * NKEY * 128 <= 9 * MiB && (size_t)NB * IKC_SUBS * 4096 <= 5 * MiB && (size_t)MROWS * 8 * 4 <= 2 * MiB && (size_t)MROWS * 1024 <= 33 * MiB, "ws map");
constexpr int CW_TMO = 0, CW_CODE = 1, CW_BAR = 4096;

__device__ __forceinline__ float bf2f(unsigned v) { return __uint_as_float(v << 16); }
__device__ __forceinline__ float bflo(unsigned v) { return __uint_as_float(v << 16); }
__device__ __forceinline__ float bfhi(unsigned v) { return __uint_as_float(v & 0xffff0000u); }
__device__ __forceinline__ unsigned cvt_pk_bf16(float lo, float hi) { unsigned r; asm volatile("v_cvt_pk_bf16_f32 %0, %1, %2" : "=v"(r) : "v"(lo), "v"(hi)); return r; }
__device__ __forceinline__ unsigned pack4_fp8(float a, float b, float c, float d) { int r = __builtin_amdgcn_cvt_pk_fp8_f32(a, b, 0, false); r = __builtin_amdgcn_cvt_pk_fp8_f32(c, d, r, true); return (unsigned)r; }
__device__ __forceinline__ float fast_exp(float x) { return __builtin_amdgcn_exp2f(x * LOG2E); }
__device__ __forceinline__ float fast_rcp(float x) { return __builtin_amdgcn_rcpf(x); }
__device__ __forceinline__ float sigmoid_f(float v) { return fast_rcp(1.f + fast_exp(-v)); }
__device__ __forceinline__ float silu_f(float v) { return v * sigmoid_f(v); }
__device__ __forceinline__ float wave_sum(float v) {
#pragma unroll
    for (int o = 1; o < 64; o <<= 1) v += __shfl_xor(v, o);
    return v;
}

namespace pg8 {
constexpr int BM = 256, BK = 64, HALF = 128, HTB = HALF * BK * 2, STAGE_BYTES = 8 * HTB, NXCD = 8, WGM = 8;
__host__ __device__ __forceinline__ int lds_byte(int r, int c) { const int st = (r >> 4) * 2 + (c >> 5), rr = r & 15, cc = c & 31, ob = rr * 64 + cc * 2; return st * 1024 + (ob ^ (((ob >> 9) & 1) << 5)); }
__host__ __device__ __forceinline__ void stage_rc(int b, int& R, int& C) { const int st = b / 1024, sb = b % 1024, swz = sb ^ (((sb >> 9) & 1) << 5); R = (st >> 1) * 16 + swz / 64; C = (st & 1) * 32 + (swz % 64) / 2; }
__host__ __device__ __forceinline__ int perm32(int rho) { const int n = rho >> 4, i = rho & 15; return 8 * (i >> 2) + 4 * n + (i & 3); }

typedef int v8i32 __attribute__((ext_vector_type(8)));
__device__ __forceinline__ v8i32 pg8_cat(bf16x8 lo, bf16x8 hi) { const u32x4 a = __builtin_bit_cast(u32x4, lo), b = __builtin_bit_cast(u32x4, hi); return (v8i32){(int)a.x, (int)a.y, (int)a.z, (int)a.w, (int)b.x, (int)b.y, (int)b.z, (int)b.w}; }
__device__ __forceinline__ void pg8_mfma8(f32x4& acc, v8i32 a, v8i32 b, int scale) {
    asm volatile("v_mfma_scale_f32_16x16x128_f8f6f4 %0, %1, %2, %0, %3, %3 op_sel_hi:[0,0,0]" : "+v"(acc) : "v"(a), "v"(b), "v"(scale)); }
struct Unit { int pm, pn; const bf16_t* A; const bf16_t* Bt; int aux; };

struct TileOrder {
    int nM, nN, nwg, G, c, rep; const bf16_t* A[2]; const bf16_t* Bt[2];
    __device__ __forceinline__ void init(int M, int N, int G_, int c_, int rep_, const bf16_t* A0, const bf16_t* B0, const bf16_t* A1, const bf16_t* B1) {
        nM = M / BM; nN = N / BM; nwg = nM * nN; G = G_; c = c_; rep = rep_; A[0] = A0; A[1] = A1; Bt[0] = B0; Bt[1] = B1; }
    __device__ __forceinline__ bool next(int ii, Unit& u) const {
        const int i = (rep == 2) ? (ii >> 1) : ii, a = (rep == 2) ? (ii & 1) : 0;
        const long L = (long)i * G + c; if (L >= nwg) return false;
        int wgid = (int)L; { const int q = nwg / NXCD, r = nwg % NXCD, xcd = wgid % NXCD, off = wgid / NXCD; wgid = (xcd < r ? xcd * (q + 1) : r * (q + 1) + (xcd - r) * q) + off; }
        const int nig = WGM * nN, gid = wgid / nig, fm = gid * WGM, gsz = (nM - fm) < WGM ? (nM - fm) : WGM;
        u.pm = fm + ((wgid % nig) % gsz); u.pn = (wgid % nig) / gsz; u.aux = a; u.A = a ? A[1] : A[0]; u.Bt = a ? Bt[1] : Bt[0]; return true;
    }
    __device__ __forceinline__ void a_ready(const Unit&) const {}
    __device__ __forceinline__ void done(const Unit&) const {}
};


struct EpiP1 {
    static constexpr bool PERM = true, AFTER_DRAIN = false;
    __device__ __forceinline__ bool keep(const Unit&) const { return false; }
    bf16_t *RQ, *RF, *RV, *AQ, *AK, *AV, *IQ, *IKC; float* IW; int pn_off; float zs;
    __device__ __forceinline__ void operator()(const f32x4 (&acc)[2][2][4][2], const Unit& u, int wr, int wc, int fr, int fq) const {
        const int pn = u.pn + pn_off, row0 = u.pm * BM + wr * 64 + fr;
        if (pn < 20) {
            bf16_t* base; int ld, colt; bool act = false;
            if (pn < 4) { base = RQ; ld = 1024; colt = pn * 256; act = true; }
            else if (pn < 8) { base = RF; ld = 1024; colt = (pn - 4) * 256; }
            else if (pn < 12) { base = RV; ld = 1024; colt = (pn - 8) * 256; }
            else if (pn < 16) { base = AQ; ld = 1024; colt = (pn - 12) * 256; }
            else if (pn == 16) { base = AK; ld = 256; colt = 0; }
            else if (pn == 17) { base = AV; ld = 256; colt = 0; }
            else { base = IQ; ld = 512; colt = (pn - 18) * 256; }
            const int col0 = colt + wc * 32 + 8 * fq;
#pragma unroll
            for (int ai = 0; ai < 2; ++ai)
#pragma unroll
                for (int m = 0; m < 4; ++m) { bf16_t* rowp = base + (size_t)(row0 + ai * HALF + m * 16) * ld + col0;
#pragma unroll
                    for (int bj = 0; bj < 2; ++bj) { f32x4 v0 = acc[ai][bj][m][0] * zs, v1 = acc[ai][bj][m][1] * zs;
                        if (act) {
#pragma unroll
                            for (int e = 0; e < 4; ++e) { v0[e] = silu_f(v0[e]) * 0.08838834764831845f; v1[e] = silu_f(v1[e]) * 0.08838834764831845f; } }
                        u32x4 w; w.x = cvt_pk_bf16(v0[0], v0[1]); w.y = cvt_pk_bf16(v0[2], v0[3]); w.z = cvt_pk_bf16(v1[0], v1[1]); w.w = cvt_pk_bf16(v1[2], v1[3]);
                        *(u32x4*)(rowp + bj * HALF) = w; } }
        } else {
            const int c8 = wc * 32 + 8 * fq;
#pragma unroll
            for (int ai = 0; ai < 2; ++ai)
#pragma unroll
                for (int m = 0; m < 4; ++m) { const int r = row0 + ai * HALF + m * 16; const f32x4 v0 = acc[ai][0][m][0] * zs, v1 = acc[ai][0][m][1] * zs;
                    if (c8 < 64) {
                        u32x4 w; w.x = cvt_pk_bf16(v0[0], v0[1]); w.y = cvt_pk_bf16(v0[2], v0[3]); w.z = cvt_pk_bf16(v1[0], v1[1]); w.w = cvt_pk_bf16(v1[2], v1[3]);
                        if (r < NTOK) { const int b = r >> 13, j = 16 + (r & (SEQ - 1)); *(u32x4*)(IKC + ((size_t)b * IKC_SUBS + (j >> 5)) * 2048 + ((c8 >> 3) * 32 + (j & 31)) * 8) = w; }
                        else if (r >= META_ROW0 && r < META_ROW0 + 16) { const int j = r - META_ROW0;
#pragma unroll
                            for (int b = 0; b < NB; ++b) *(u32x4*)(IKC + ((size_t)b * IKC_SUBS + (j >> 5)) * 2048 + ((c8 >> 3) * 32 + (j & 31)) * 8) = w; }
                    } else if (c8 == 64) {
                        if (r < NTOK) { const float sc = 0.044194173824159216f;
                            *(f32x4*)(IW + (size_t)r * 8) = v0 * sc; *(f32x4*)(IW + (size_t)r * 8 + 4) = v1 * sc; }
                    } }
        }
    }
};
struct EpiP4 {
    static constexpr bool PERM = true, AFTER_DRAIN = false;
    __device__ __forceinline__ bool keep(const Unit&) const { return false; }
    unsigned char* ws;
    __device__ __forceinline__ void operator()(const f32x4 (&acc)[2][2][4][2], const Unit& u, int wr, int wc, int fr, int fq) const {
        const int pn = u.pn, row0 = u.pm * BM + wr * 64 + fr; const bool gate = pn < 8;
        const size_t boff = pn < 4 ? WS_RQ : pn < 8 ? WS_AQ : pn < 12 ? WS_RF : WS_RV;
        bf16_t* base = (bf16_t*)(ws + boff); unsigned char* g8 = ws + (pn < 4 ? WS_GR8 : WS_GA8);
        const int col0 = (pn & 3) * 256 + wc * 32 + 8 * fq;
        constexpr int PD = 7; u32x4 oq[PD + 1][2];
        if (gate) {
#pragma unroll
            for (int it = 0; it < PD; ++it)
#pragma unroll
                for (int bj = 0; bj < 2; ++bj) oq[it][bj] = *(const u32x4*)(base + (size_t)(row0 + (it >> 2) * HALF + (it & 3) * 16) * 1024 + col0 + bj * HALF); }
#pragma unroll
        for (int ai = 0; ai < 2; ++ai)
#pragma unroll
            for (int m = 0; m < 4; ++m) { const int it = ai * 4 + m; const size_t ro = (size_t)(row0 + ai * HALF + m * 16) * 1024 + col0; bf16_t* rowp = base + ro;
                if (gate && it + PD < 8) { const int ai2 = (it + PD) >> 2, m2 = (it + PD) & 3;
#pragma unroll
                    for (int bj = 0; bj < 2; ++bj) oq[(it + PD) % (PD + 1)][bj] = *(const u32x4*)(base + (size_t)(row0 + ai2 * HALF + m2 * 16) * 1024 + col0 + bj * HALF); }
#pragma unroll
                for (int bj = 0; bj < 2; ++bj) { f32x4 v0 = acc[ai][bj][m][0] * ZSCALE, v1 = acc[ai][bj][m][1] * ZSCALE;
                    if (gate) { const u32x4 o = oq[it % (PD + 1)][bj];
                        v0[0] = silu_f(v0[0]) * bflo(o.x); v0[1] = silu_f(v0[1]) * bfhi(o.x); v0[2] = silu_f(v0[2]) * bflo(o.y); v0[3] = silu_f(v0[3]) * bfhi(o.y);
                        v1[0] = silu_f(v1[0]) * bflo(o.z); v1[1] = silu_f(v1[1]) * bfhi(o.z); v1[2] = silu_f(v1[2]) * bflo(o.w); v1[3] = silu_f(v1[3]) * bfhi(o.w);
                        u32x2 w8; w8.x = pack4_fp8(v0[0], v0[1], v0[2], v0[3]); w8.y = pack4_fp8(v1[0], v1[1], v1[2], v1[3]);
                        *(u32x2*)(g8 + ro + bj * HALF) = w8;
                    } else {
#pragma unroll
                        for (int e = 0; e < 4; ++e) { v0[e] = sigmoid_f(v0[e]); v1[e] = sigmoid_f(v1[e]); }
                        u32x4 w; w.x = cvt_pk_bf16(v0[0], v0[1]); w.y = cvt_pk_bf16(v0[2], v0[3]); w.z = cvt_pk_bf16(v1[0], v1[1]); w.w = cvt_pk_bf16(v1[2], v1[3]);
                        *(u32x4*)(rowp + bj * HALF) = w; } }
                asm volatile("" ::: "memory"); }
    }
};
struct EpiP5 {
    static constexpr bool PERM = true, AFTER_DRAIN = false;
    __device__ __forceinline__ bool keep(const Unit& u) const { return u.aux == 0; }
    const bf16_t *SMR, *SMA; unsigned char* MG;
    __device__ __forceinline__ void operator()(f32x4 (&acc)[2][2][4][2], const Unit& u, int wr, int wc, int fr, int fq) const {
        const int row0 = u.pm * BM + wr * 64 + fr, col0 = u.pn * BM + wc * 32 + 8 * fq; const bool second = u.aux != 0;
        if (!second) {
#pragma unroll
            for (int ai = 0; ai < 2; ++ai) { u32x4 sa[4][2], sr[4][2];
#pragma unroll
                for (int m = 0; m < 4; ++m)
#pragma unroll
                    for (int bj = 0; bj < 2; ++bj) { const size_t o2 = (size_t)(row0 + ai * HALF + m * 16) * 1024 + col0 + bj * HALF;
                        sa[m][bj] = *(const u32x4*)(SMA + o2); sr[m][bj] = *(const u32x4*)(SMR + o2); }
#pragma unroll
                for (int m = 0; m < 4; ++m)
#pragma unroll
                    for (int bj = 0; bj < 2; ++bj) { const u32x4 a = sa[m][bj], s = sr[m][bj]; f32x4 v0 = acc[ai][bj][m][0], v1 = acc[ai][bj][m][1];
                        v0[0] *= bflo(s.x) * fast_rcp(fmaxf(bflo(a.x), 1e-30f)); v0[1] *= bfhi(s.x) * fast_rcp(fmaxf(bfhi(a.x), 1e-30f));
                        v0[2] *= bflo(s.y) * fast_rcp(fmaxf(bflo(a.y), 1e-30f)); v0[3] *= bfhi(s.y) * fast_rcp(fmaxf(bfhi(a.y), 1e-30f));
                        v1[0] *= bflo(s.z) * fast_rcp(fmaxf(bflo(a.z), 1e-30f)); v1[1] *= bfhi(s.z) * fast_rcp(fmaxf(bfhi(a.z), 1e-30f));
                        v1[2] *= bflo(s.w) * fast_rcp(fmaxf(bflo(a.w), 1e-30f)); v1[3] *= bfhi(s.w) * fast_rcp(fmaxf(bfhi(a.w), 1e-30f));
                        acc[ai][bj][m][0] = v0; acc[ai][bj][m][1] = v1; } }
        } else { u32x4 sa[2][4][2];
#pragma unroll
            for (int ai = 0; ai < 2; ++ai)
#pragma unroll
                for (int m = 0; m < 4; ++m)
#pragma unroll
                    for (int bj = 0; bj < 2; ++bj) sa[ai][m][bj] = *(const u32x4*)(SMA + (size_t)(row0 + ai * HALF + m * 16) * 1024 + col0 + bj * HALF);
#pragma unroll
            for (int ai = 0; ai < 2; ++ai)
#pragma unroll
                for (int m = 0; m < 4; ++m)
#pragma unroll
                    for (int bj = 0; bj < 2; ++bj) { const u32x4 a = sa[ai][m][bj]; const f32x4 v0 = acc[ai][bj][m][0], v1 = acc[ai][bj][m][1]; u32x2 w;
                        w.x = pack4_fp8(v0[0] * fmaxf(bflo(a.x), 1e-30f) * ZSCALE, v0[1] * fmaxf(bfhi(a.x), 1e-30f) * ZSCALE, v0[2] * fmaxf(bflo(a.y), 1e-30f) * ZSCALE, v0[3] * fmaxf(bfhi(a.y), 1e-30f) * ZSCALE);
                        w.y = pack4_fp8(v1[0] * fmaxf(bflo(a.z), 1e-30f) * ZSCALE, v1[1] * fmaxf(bfhi(a.z), 1e-30f) * ZSCALE, v1[2] * fmaxf(bflo(a.w), 1e-30f) * ZSCALE, v1[3] * fmaxf(bfhi(a.w), 1e-30f) * ZSCALE);
                        *(u32x2*)(MG + (size_t)(row0 + ai * HALF + m * 16) * 1024 + col0 + bj * HALF) = w; }
        }
    }
};
struct EpiP6 {
    static constexpr bool PERM = true, AFTER_DRAIN = false;
    __device__ __forceinline__ bool keep(const Unit&) const { return false; }
    const float* X; float* OUT;
    __device__ __forceinline__ void operator()(const f32x4 (&acc)[2][2][4][2], const Unit& u, int wr, int wc, int fr, int fq) const {
        const int row0 = u.pm * BM + wr * 64 + fr, col0 = u.pn * BM + wc * 32 + 8 * fq;
#pragma unroll
        for (int ai = 0; ai < 2; ++ai) { f32x4 xv[4][2][2];
#pragma unroll
            for (int m = 0; m < 4; ++m)
#pragma unroll
                for (int bj = 0; bj < 2; ++bj)
#pragma unroll
                    for (int n = 0; n < 2; ++n) xv[m][bj][n] = *(const f32x4*)(X + (size_t)(row0 + ai * HALF + m * 16) * 1024 + col0 + bj * HALF + n * 4);
#pragma unroll
            for (int m = 0; m < 4; ++m)
#pragma unroll
                for (int bj = 0; bj < 2; ++bj)
#pragma unroll
                    for (int n = 0; n < 2; ++n) *(f32x4*)(OUT + (size_t)(row0 + ai * HALF + m * 16) * 1024 + col0 + bj * HALF + n * 4) = xv[m][bj][n] + acc[ai][bj][m][n] * ZSCALE; }
    }
};

template <class Epi, class Sched, bool ALIGN_EPI = false, bool SP2 = false, bool FP8 = false>
__device__ __forceinline__ void gemm_phase(PG8_LAS unsigned char* lds, const int K, const Sched& S, const Epi& E) {
    const int tid = threadIdx.x, wid = __builtin_amdgcn_readfirstlane(tid >> 6), lane = tid & 63, wr = wid >> 2, wc = wid & 3, fr = lane & 15, fq = lane >> 4;
    const int nt = K / BK;
    unsigned voffA[2], voffB[2];
#pragma unroll
    for (int i = 0; i < 2; ++i) { int R, C; stage_rc(tid * 16 + i * 8192, R, C); const int Rb = Epi::PERM ? ((R & ~31) + perm32(R & 31)) : R;
        voffA[i] = (unsigned)(R * K + C) * 2u; voffB[i] = (unsigned)(Rb * K + C) * 2u; }
    const size_t kstep = (size_t)(BK * 2);
    const size_t hstep = (size_t)HALF * K * 2;
    const size_t tstep = 2 * hstep;
    const unsigned ldsw = (unsigned)wid * 1024u;
    const int aoff = lds_byte(wr * 64 + fr, fq * 8), boff = lds_byte(wc * 32 + fr, fq * 8);
#define PG8_SA(b, h) (((b) * 2 + (h)) * HTB)
#define PG8_SB(b, h) ((4 + (b) * 2 + (h)) * HTB)
#define PG8_STAGE(bufoff, gbase, voff) do { _Pragma("unroll") for (int _i = 0; _i < 2; ++_i) \
        __builtin_amdgcn_global_load_lds((const unsigned*)((const char*)(gbase) + (voff)[_i]), (PG8_LAS unsigned*)(lds + (bufoff) + ldsw + _i * 8192), 16, 0, 0); } while (0)
#define PG8_LDA(dst, b, h) do { _Pragma("unroll") for (int m = 0; m < 4; ++m) _Pragma("unroll") for (int k = 0; k < 2; ++k) dst[m][k] = *(const PG8_LAS bf16x8*)(lds + PG8_SA(b, h) + aoff + m * 2048 + k * 1024); } while (0)
#define PG8_LDB(dst, b, h) do { _Pragma("unroll") for (int n = 0; n < 2; ++n) _Pragma("unroll") for (int k = 0; k < 2; ++k) dst[n][k] = *(const PG8_LAS bf16x8*)(lds + PG8_SB(b, h) + boff + n * 2048 + k * 1024); } while (0)
#define PG8_MMA(ai, bj, At, Bt) do { __builtin_amdgcn_s_setprio(1); _Pragma("unroll") for (int m = 0; m < 4; ++m) _Pragma("unroll") for (int n = 0; n < 2; ++n) { \
        if constexpr (FP8) { pg8_mfma8(acc[ai][bj][m][n], pg8_cat(Bt[n][0], Bt[n][1]), pg8_cat(At[m][0], At[m][1]), one8); } \
        else { _Pragma("unroll") for (int k = 0; k < 2; ++k) acc[ai][bj][m][n] = __builtin_amdgcn_mfma_f32_16x16x32_bf16(Bt[n][k], At[m][k], acc[ai][bj][m][n], 0, 0, 0); } } __builtin_amdgcn_s_setprio(0); } while (0)
#define PG8_WAIT_V(n) asm volatile("s_waitcnt vmcnt(" #n ")" ::: "memory")
#define PG8_WAIT_L(n) asm volatile("s_waitcnt lgkmcnt(" #n ")" ::: "memory")
#define PG8_BAR __builtin_amdgcn_s_barrier()
#define PG8_SCHED __builtin_amdgcn_sched_barrier(0)
    Unit cur, nxt; int ui = 0;
    if (!S.next(0, cur)) return;
    f32x4 acc[2][2][4][2];
    const int one8 = 0x7f7f7f7f;
#pragma unroll
    for (int a = 0; a < 2; ++a)
#pragma unroll
        for (int b = 0; b < 2; ++b)
#pragma unroll
            for (int m = 0; m < 4; ++m)
#pragma unroll
                for (int n = 0; n < 2; ++n) acc[a][b][m][n] = (f32x4){0.f, 0.f, 0.f, 0.f};
    bf16x8 At[4][2], B0[2][2], B1[2][2];
    const char* cA = (const char*)cur.A + (size_t)cur.pm * tstep; const char* cB = (const char*)cur.Bt + (size_t)cur.pn * tstep;
    S.a_ready(cur);
    if constexpr (SP2) {
        PG8_STAGE(PG8_SB(0, 0), cB, voffB); PG8_STAGE(PG8_SB(0, 1), cB + hstep, voffB); PG8_STAGE(PG8_SA(0, 0), cA, voffA); PG8_STAGE(PG8_SA(0, 1), cA + hstep, voffA);
        if (wr == 1) PG8_BAR;
        PG8_WAIT_V(2); PG8_BAR;
        PG8_STAGE(PG8_SB(1, 0), cB + kstep, voffB); PG8_STAGE(PG8_SA(1, 0), cA + kstep, voffA); PG8_STAGE(PG8_SB(1, 1), cB + hstep + kstep, voffB);
        PG8_WAIT_V(6); PG8_BAR;
    } else {
        PG8_STAGE(PG8_SB(0, 0), cB, voffB); PG8_STAGE(PG8_SA(0, 0), cA, voffA); PG8_STAGE(PG8_SB(0, 1), cB + hstep, voffB); PG8_STAGE(PG8_SA(0, 1), cA + hstep, voffA);
        if (wr == 1) PG8_BAR;
        PG8_WAIT_V(4); PG8_BAR;
        PG8_STAGE(PG8_SB(1, 0), cB + kstep, voffB); PG8_STAGE(PG8_SA(1, 0), cA + kstep, voffA); PG8_STAGE(PG8_SB(1, 1), cB + hstep + kstep, voffB);
        PG8_WAIT_V(6); PG8_BAR;
    }
    for (;;) {
        const bool has_next = S.next(ui + 1, nxt);
        const char* nA = has_next ? (const char*)nxt.A + (size_t)nxt.pm * tstep : cA; const char* nB = has_next ? (const char*)nxt.Bt + (size_t)nxt.pn * tstep : cB;
#pragma unroll 1
        for (int t = 0; t < nt; t += 2) {
            const bool last = (t == nt - 2);
            const char* a1 = cA + (size_t)(t + 1) * kstep;
            const char* a2 = last ? nA : cA + (size_t)(t + 2) * kstep; const char* b2 = last ? nB : cB + (size_t)(t + 2) * kstep;
            const char* a3 = a2 + kstep; const char* b3 = b2 + kstep;
            if (last && has_next) S.a_ready(nxt);
            if constexpr (SP2) {
            PG8_LDB(B0, 0, 0); PG8_LDB(B1, 0, 1); PG8_SCHED; PG8_LDA(At, 0, 0); PG8_STAGE(PG8_SA(1, 1), a1 + hstep, voffA);
            PG8_WAIT_V(8); PG8_WAIT_L(0); PG8_BAR; PG8_MMA(0, 0, At, B0); PG8_MMA(0, 1, At, B1); PG8_BAR; PG8_SCHED;
            PG8_LDA(At, 0, 1); PG8_STAGE(PG8_SB(0, 0), b2, voffB); PG8_STAGE(PG8_SB(0, 1), b2 + hstep, voffB); PG8_STAGE(PG8_SA(0, 0), a2, voffA);
            PG8_WAIT_V(8); PG8_WAIT_L(0); PG8_BAR; PG8_MMA(1, 0, At, B0); PG8_MMA(1, 1, At, B1); PG8_BAR; PG8_SCHED;
            PG8_LDB(B0, 1, 0); PG8_LDB(B1, 1, 1); PG8_SCHED; PG8_LDA(At, 1, 0); PG8_STAGE(PG8_SA(0, 1), a2 + hstep, voffA);
            PG8_WAIT_V(8); PG8_WAIT_L(0); PG8_BAR; PG8_MMA(0, 0, At, B0); PG8_MMA(0, 1, At, B1); PG8_BAR; PG8_SCHED;
            PG8_LDA(At, 1, 1); PG8_STAGE(PG8_SB(1, 0), b3, voffB); PG8_STAGE(PG8_SB(1, 1), b3 + hstep, voffB); PG8_STAGE(PG8_SA(1, 0), a3, voffA);
            PG8_WAIT_V(8); PG8_WAIT_L(0); PG8_BAR; PG8_MMA(1, 0, At, B0); PG8_MMA(1, 1, At, B1); PG8_BAR; PG8_SCHED;
            } else {
            PG8_LDB(B0, 0, 0); PG8_SCHED; PG8_LDA(At, 0, 0); PG8_STAGE(PG8_SA(1, 1), a1 + hstep, voffA);
            PG8_WAIT_L(8); PG8_BAR; PG8_WAIT_L(0); PG8_MMA(0, 0, At, B0); PG8_BAR; PG8_SCHED;
            PG8_LDB(B1, 0, 1); PG8_STAGE(PG8_SB(0, 0), b2, voffB);
            PG8_BAR; PG8_WAIT_L(0); PG8_MMA(0, 1, At, B1); PG8_BAR;
            PG8_LDA(At, 0, 1); PG8_STAGE(PG8_SA(0, 0), a2, voffA);
            PG8_BAR; PG8_WAIT_L(0); PG8_MMA(1, 0, At, B0); PG8_BAR; PG8_SCHED;
            PG8_STAGE(PG8_SB(0, 1), b2 + hstep, voffB);
            PG8_WAIT_V(6); PG8_BAR; PG8_MMA(1, 1, At, B1); PG8_BAR;
            PG8_LDB(B0, 1, 0); PG8_SCHED; PG8_LDA(At, 1, 0); PG8_STAGE(PG8_SA(0, 1), a2 + hstep, voffA);
            PG8_WAIT_L(8); PG8_BAR; PG8_WAIT_L(0); PG8_MMA(0, 0, At, B0); PG8_BAR; PG8_SCHED;
            PG8_LDB(B1, 1, 1); PG8_STAGE(PG8_SB(1, 0), b3, voffB);
            PG8_BAR; PG8_WAIT_L(0); PG8_MMA(0, 1, At, B1); PG8_BAR;
            PG8_LDA(At, 1, 1); PG8_STAGE(PG8_SA(1, 0), a3, voffA);
            PG8_BAR; PG8_WAIT_L(0); PG8_MMA(1, 0, At, B0); PG8_BAR; PG8_SCHED;
            PG8_STAGE(PG8_SB(1, 1), b3 + hstep, voffB);
            PG8_WAIT_V(6); PG8_BAR; PG8_MMA(1, 1, At, B1); PG8_BAR;
            }
        }
        if constexpr (ALIGN_EPI) { if (wr == 0) PG8_BAR; }
        if constexpr (FP8) {
#pragma unroll
            for (int a_ = 0; a_ < 2; ++a_) asm volatile("s_nop 15\n\ts_nop 15" : "+v"(acc[a_][0][0][0]), "+v"(acc[a_][0][0][1]), "+v"(acc[a_][0][1][0]), "+v"(acc[a_][0][1][1]), "+v"(acc[a_][0][2][0]), "+v"(acc[a_][0][2][1]), "+v"(acc[a_][0][3][0]), "+v"(acc[a_][0][3][1]),
                                                                        "+v"(acc[a_][1][0][0]), "+v"(acc[a_][1][0][1]), "+v"(acc[a_][1][1][0]), "+v"(acc[a_][1][1][1]), "+v"(acc[a_][1][2][0]), "+v"(acc[a_][1][2][1]), "+v"(acc[a_][1][3][0]), "+v"(acc[a_][1][3][1]));
        }
        if constexpr (!Epi::AFTER_DRAIN) { E(acc, cur, wr, wc, fr, fq); S.done(cur); }
        if (!has_next) break;
        if (!E.keep(cur)) {
#pragma unroll
        for (int a = 0; a < 2; ++a)
#pragma unroll
            for (int b = 0; b < 2; ++b)
#pragma unroll
                for (int m = 0; m < 4; ++m)
#pragma unroll
                    for (int n = 0; n < 2; ++n) acc[a][b][m][n] = (f32x4){0.f, 0.f, 0.f, 0.f};
        }
        cur = nxt; cA = nA; cB = nB; ++ui;
        if constexpr (ALIGN_EPI) { if (wr == 1) PG8_BAR; }
    }
    PG8_WAIT_V(0);
    if constexpr (!ALIGN_EPI) { if (wr == 0) PG8_BAR; }
    PG8_BAR;
    if constexpr (Epi::AFTER_DRAIN) { E.fused(acc, cur, wr, wc, fr, fq, lds, wid, lane); S.done(cur); }
#undef PG8_SA
#undef PG8_SB
#undef PG8_STAGE
#undef PG8_LDA
#undef PG8_LDB
#undef PG8_MMA
#undef PG8_WAIT_V
#undef PG8_WAIT_L
#undef PG8_BAR
#undef PG8_SCHED
}
}

constexpr int RING_BYTES = 131072;
constexpr int LDSCTL_OFF = 143360, MISC_OFF = LDSCTL_OFF + 320;
constexpr int LDS_BYTES = 147456;
constexpr int NWAVES = 8;

#define LDS_WAIT() asm volatile("s_waitcnt lgkmcnt(0)" ::: "memory")
#define VM_WAIT() asm volatile("s_waitcnt vmcnt(0)" ::: "memory")

#define XB_TMO      128
#define XB_XCNT(j)  (256  + 64 * (j))
#define XB_XSUB(j)  (1280 + 64 * (j))
#define XB_XGEN(j)  (2304 + 64 * (j))
#define XB_TOP      3328
#define XB_TOPGEN   3392
#define XCD_BAR_WORDS 3456
#define XB_SPIN_CAP (1u << 18)

__device__ __forceinline__ unsigned xb_ld(unsigned* p)              { return __hip_atomic_load(p, __ATOMIC_RELAXED, __HIP_MEMORY_SCOPE_AGENT); }
__device__ __forceinline__ unsigned xb_add(unsigned* p, unsigned v) { return __hip_atomic_fetch_add(p, v, __ATOMIC_RELAXED, __HIP_MEMORY_SCOPE_AGENT); }
__device__ __forceinline__ unsigned xb_xcc_id() { return (unsigned)__builtin_amdgcn_s_getreg((3 << 11) | 20) & 0xFu; }
#define XB_SPIN(cond, bar) do { unsigned _sp = 0; while (cond) { __builtin_amdgcn_s_sleep(1); \
    if ((++_sp & 255u) == 0u) { if (xb_ld(&(bar)[XB_TMO])) break; if (_sp > XB_SPIN_CAP) { atomicAdd(&(bar)[XB_TMO], 1u); break; } } } } while (0)

struct XcdBarrier {
    unsigned* bar; unsigned x;
    volatile LAS unsigned* st;
};

__device__ __forceinline__ XcdBarrier xcd_barrier_post(unsigned* bar, volatile LAS unsigned* st) {
    XcdBarrier b; b.bar = bar; b.x = xb_xcc_id(); b.st = st;
    if (threadIdx.x == 0) (void)xb_add(&bar[XB_XCNT(b.x)], 1u);
    return b;
}
__device__ __forceinline__ void xcd_barrier_complete(unsigned* bar, unsigned x, unsigned& nloc, unsigned& nx) {
    const unsigned G = gridDim.x * gridDim.y * gridDim.z;
    unsigned sum, cnt, mine, sp = 0u;
    for (;;) {
        sum = 0u; cnt = 0u; mine = 0u;
#pragma unroll
        for (unsigned j = 0; j < 16; ++j) { const unsigned c = xb_ld(&bar[XB_XCNT(j)]); sum += c; cnt += (c > 0u) ? 1u : 0u; mine = (j == x) ? c : mine; }
        if (sum == G) break;
        __builtin_amdgcn_s_sleep(1);
        if ((++sp & 255u) == 0u) { if (xb_ld(&bar[XB_TMO])) break; if (sp > XB_SPIN_CAP) { atomicAdd(&bar[XB_TMO], 1u); break; } }
    }
    nloc = mine > 0u ? mine : 1u; nx = cnt > 0u ? cnt : 1u;
}

__device__ __forceinline__ void xcd_barrier(const XcdBarrier& b) {
    asm volatile("s_waitcnt vmcnt(0)" ::: "memory");
    __syncthreads();
    if (threadIdx.x == 0) {
        unsigned* bar = b.bar;
        __builtin_amdgcn_s_waitcnt(0);
        unsigned nloc = b.st[0], nx = b.st[1];
        if (nloc == 0u) { xcd_barrier_complete(bar, b.x, nloc, nx); b.st[0] = nloc; b.st[1] = nx; }
        const unsigned old = xb_add(&bar[XB_XSUB(b.x)], 1u);
        const unsigned gen = old / nloc;
        if (old + 1u == (gen + 1u) * nloc) {
            __builtin_amdgcn_fence(__ATOMIC_RELEASE, "agent");
            asm volatile("s_waitcnt vmcnt(0)" ::: "memory");
            const unsigned og = xb_add(&bar[XB_TOP], 1u);
            const unsigned tg = og / nx;
            if (og + 1u == (tg + 1u) * nx) xb_add(&bar[XB_TOPGEN], 1u);
            else XB_SPIN(xb_ld(&bar[XB_TOPGEN]) == tg, bar);
            __builtin_amdgcn_fence(__ATOMIC_ACQUIRE, "agent");
            xb_add(&bar[XB_XGEN(b.x)], 1u);
            asm volatile("s_waitcnt vmcnt(0)" ::: "memory");
        } else {
            XB_SPIN(xb_ld(&bar[XB_XGEN(b.x)]) == gen, bar);
            __builtin_amdgcn_fence(__ATOMIC_ACQUIRE, "agent");
            asm volatile("s_waitcnt vmcnt(0)" ::: "memory");
        }
    }
    __syncthreads();
}


struct Frame {
    LAS unsigned char* lds;
    int tid, lane, wave, vcu, G;
};

__device__ __forceinline__ int src_col_1a(int n) {
    if (n < 3072) return n;
    if (n < 4096) return C_AQ + (n - 3072);
    if (n < 4608) return C_AK + (n - 4096);
    if (n < 5120) return C_IQ + (n - 4608);
    if (n < 5192) return C_IK + (n - 5120);
    return -1;
}
__device__ __forceinline__ int src_col_1b(int n) {
    if (n < 1024) return C_RG + n;
    if (n < 2048) return C_AG + (n - 1024);
    return C_MR + (n - 2048);
}
template <bool FP8>
__device__ __forceinline__ void p0_transpose_item(const float* W, int ldw, int mode, int n_base, void* WT, int nblk, LAS float* scr, int item, int lane) {
    const int kb = item / nblk, nb = item % nblk, k0 = 64 * kb, n0 = 32 * nb;
    const int n = n_base + n0 + (lane & 31); const int sc = mode == 0 ? n : mode == 1 ? src_col_1a(n) : src_col_1b(n);
    { float wv_[32];
#pragma unroll
      for (int i = 0; i < 32; ++i) { const int kk = 2 * i + (lane >> 5); wv_[i] = sc >= 0 ? W[(size_t)(k0 + kk) * ldw + sc] : 0.f; }
#pragma unroll
      for (int i = 0; i < 32; ++i) { const int kk = 2 * i + (lane >> 5); scr[kk * 33 + (lane & 31)] = wv_[i]; } }
    LDS_WAIT(); asm volatile("" ::: "memory");
    const int c = lane & 7;
#pragma unroll
    for (int j = 0; j < 4; ++j) { const int nn = (lane >> 3) + 8 * j; const LAS float* s = scr + (8 * c) * 33 + nn;
        if (FP8) { u32x2 o; o.x = pack4_fp8(s[0 * 33] * WSCALE, s[1 * 33] * WSCALE, s[2 * 33] * WSCALE, s[3 * 33] * WSCALE); o.y = pack4_fp8(s[4 * 33] * WSCALE, s[5 * 33] * WSCALE, s[6 * 33] * WSCALE, s[7 * 33] * WSCALE);
            *(u32x2*)((unsigned char*)WT + (size_t)(n0 + nn) * 1024 + k0 + 8 * c) = o; }
        else { u32x4 o; o.x = cvt_pk_bf16(s[0 * 33], s[1 * 33]); o.y = cvt_pk_bf16(s[2 * 33], s[3 * 33]); o.z = cvt_pk_bf16(s[4 * 33], s[5 * 33]); o.w = cvt_pk_bf16(s[6 * 33], s[7 * 33]);
            *(u32x4*)((bf16_t*)WT + (size_t)(n0 + nn) * 1024 + k0 + 8 * c) = o; } }
    LDS_WAIT(); asm volatile("" ::: "memory");
}
__device__ __forceinline__ void rms_row_to_bf16(const float* xrow, const float* g, bf16_t* orow, unsigned char* orow8, int lane) {
    const f32x4* xr = (const f32x4*)xrow + lane; const f32x4* gr = (const f32x4*)g + lane;
    f32x4 v[4]; float s = 0.f;
#pragma unroll
    for (int j = 0; j < 4; ++j) { v[j] = xr[64 * j]; s += (v[j].x * v[j].x + v[j].y * v[j].y) + (v[j].z * v[j].z + v[j].w * v[j].w); }
    const float rstd = __builtin_amdgcn_rsqf(wave_sum(s) * (1.f / 1024.f) + EPS);
    u32x2* o8 = (u32x2*)orow + lane; unsigned* o4 = (unsigned*)orow8 + lane;
#pragma unroll
    for (int j = 0; j < 4; ++j) { const f32x4 gg = gr[64 * j]; const float a = v[j].x * rstd * gg.x, b = v[j].y * rstd * gg.y, c = v[j].z * rstd * gg.z, d = v[j].w * rstd * gg.w;
        u32x2 w; w.x = cvt_pk_bf16(a, b); w.y = cvt_pk_bf16(c, d); o8[64 * j] = w; o4[64 * j] = pack4_fp8(a, b, c, d); }
}
struct P0Args { const float *x, *meta, *norm_g, *w_in, *lb_logits, *w_r, *w_a, *w_out; unsigned char *W1A8, *W1B8, *WR8, *WA8, *WO8, *XN8; bf16_t *W1AI, *XN; float* LB; };
__device__ __forceinline__ void p0_prologue(const Frame& F, const P0Args& a) {
    LAS float* scr = (LAS float*)(F.lds + F.wave * 16384);
    const int gw = F.vcu * NWAVES + F.wave, NGW = F.G * NWAVES;
    constexpr int I_A = 16 * (N1A8 / 32), I_I = 16 * (N1AI / 32), I_B = 16 * (N1B / 32), I_S = 16 * 32;
    constexpr int NITEMS = I_A + I_I + I_B + 3 * I_S;
    for (int it = gw; it < NITEMS; it += NGW) {
        int r = it;
        if (r < I_A) { p0_transpose_item<true>(a.w_in, D_IN, 1, 0, a.W1A8, N1A8 / 32, scr, r, F.lane); continue; } r -= I_A;
        if (r < I_I) { p0_transpose_item<false>(a.w_in, D_IN, 1, N1A8, a.W1AI, N1AI / 32, scr, r, F.lane); continue; } r -= I_I;
        if (r < I_B) { p0_transpose_item<true>(a.w_in, D_IN, 2, 0, a.W1B8, N1B / 32, scr, r, F.lane); continue; } r -= I_B;
        if (r < I_S) { p0_transpose_item<true>(a.w_r, 1024, 0, 0, a.WR8, 32, scr, r, F.lane); continue; } r -= I_S;
        if (r < I_S) { p0_transpose_item<true>(a.w_a, 1024, 0, 0, a.WA8, 32, scr, r, F.lane); continue; } r -= I_S;
        p0_transpose_item<true>(a.w_out, 1024, 0, 0, a.WO8, 32, scr, r, F.lane);
    }
    { constexpr int RPP = 8; f32x4 gg[4];
#pragma unroll
      for (int j = 0; j < 4; ++j) gg[j] = ((const f32x4*)a.norm_g)[F.lane + 64 * j];
      for (int m0 = gw; m0 < NTOK; m0 += RPP * NGW) {
        f32x4 v[RPP][4]; float s[RPP];
#pragma unroll
        for (int q = 0; q < RPP; ++q) { const int m = m0 + q * NGW; const f32x4* xr = (const f32x4*)(a.x + (size_t)(m < NTOK ? m : m0) * DM) + F.lane;
#pragma unroll
            for (int j = 0; j < 4; ++j) v[q][j] = xr[64 * j]; }
#pragma unroll
        for (int q = 0; q < RPP; ++q) { float t = 0.f;
#pragma unroll
            for (int j = 0; j < 4; ++j) t += (v[q][j].x * v[q][j].x + v[q][j].y * v[q][j].y) + (v[q][j].z * v[q][j].z + v[q][j].w * v[q][j].w);
            s[q] = t; }
#pragma unroll
        for (int o = 1; o < 64; o <<= 1) {
#pragma unroll
            for (int q = 0; q < RPP; ++q) s[q] += __shfl_xor(s[q], o); }
#pragma unroll
        for (int q = 0; q < RPP; ++q) { const int m = m0 + q * NGW; if (m >= NTOK) continue;
            const float rstd = __builtin_amdgcn_rsqf(s[q] * (1.f / 1024.f) + EPS);
            u32x2* o8 = (u32x2*)(a.XN + (size_t)m * DM) + F.lane; unsigned* o4 = (unsigned*)(a.XN8 + (size_t)m * DM) + F.lane;
#pragma unroll
            for (int j = 0; j < 4; ++j) { const float c0 = v[q][j].x * rstd * gg[j].x, c1 = v[q][j].y * rstd * gg[j].y, c2 = v[q][j].z * rstd * gg[j].z, c3 = v[q][j].w * rstd * gg[j].w;
                u32x2 w; w.x = cvt_pk_bf16(c0, c1); w.y = cvt_pk_bf16(c2, c3); o8[64 * j] = w; o4[64 * j] = pack4_fp8(c0, c1, c2, c3); } } } }
    for (int m = NTOK + gw; m < MROWS; m += NGW) {
        if (m < NTOK) rms_row_to_bf16(a.x + (size_t)m * DM, a.norm_g, a.XN + (size_t)m * DM, a.XN8 + (size_t)m * DM, F.lane);
        else if (m >= META_ROW0 && m < META_ROW0 + 16) rms_row_to_bf16(a.meta + (size_t)(m - META_ROW0) * DM, a.norm_g, a.XN + (size_t)m * DM, a.XN8 + (size_t)m * DM, F.lane);
        else { u32x2* o8 = (u32x2*)(a.XN + (size_t)m * DM) + F.lane; unsigned* o4 = (unsigned*)(a.XN8 + (size_t)m * DM) + F.lane; const u32x2 z = {0u, 0u};
#pragma unroll
            for (int j = 0; j < 4; ++j) { o8[64 * j] = z; o4[64 * j] = 0u; } }
    }
    if (blockIdx.x == 0) {
        for (int k = F.tid; k < 1024; k += NWAVES * 64) { const float l0 = a.lb_logits[k], l1 = a.lb_logits[1024 + k]; a.LB[k] = 1.f / (1.f + __expf(l1 - l0)); }
    }
}

constexpr int HG_QT = 0, HG_KT = 17408, HG_KHT = 34816, HG_VT = 53248, HG_PL = 71680, HG_SW = 80896, HG_OT = 115712, HG_PART = 133120, HG_DV = 137216, HG_P2 = 137728, HG_END = 139776;
static_assert(HG_END <= LDSCTL_OFF, "HGRN LDS map");
struct HgArgs { const bf16_t *RQ, *RF, *RV; bf16_t* OR_; const float *LB, *RNG; float *SLOC, *DSEG; };

template <int CTRL> __device__ __forceinline__ float dpp_f_(float v) { return __builtin_bit_cast(float, __builtin_amdgcn_update_dpp(0, __builtin_bit_cast(int, v), CTRL, 0xf, 0xf, true)); }
#define dpp_f(v, ctrl) dpp_f_<ctrl>(v)
__device__ __forceinline__ f32x4 mfma16(bf16x8 a, bf16x8 b, f32x4 c) { return __builtin_amdgcn_mfma_f32_16x16x32_bf16(a, b, c, 0, 0, 0); }
__device__ __forceinline__ bf16x8 lds_b128(LAS unsigned char* p) { return *(LAS bf16x8*)p; }

struct HgRegs { unsigned F2[8], V2[8], Q2[8]; };
template <bool FULL>
__device__ __forceinline__ void hg_load(HgRegs& R, const HgArgs& A, size_t row0, int h, int lane, int w) {
    const size_t cb = row0 * 1024 + (size_t)h * 128 + 2 * lane;
#pragma unroll
    for (int i = 0; i < 8; ++i) { const size_t o = cb + (size_t)(8 * w + i) * 1024; R.F2[i] = *(const unsigned*)(A.RF + o); R.V2[i] = *(const unsigned*)(A.RV + o); if (FULL) R.Q2[i] = *(const unsigned*)(A.RQ + o); }
}
template <bool FULL>
__device__ __forceinline__ void hg_chunk(LAS unsigned char* lds, const HgArgs& A, const HgRegs& R, size_t row0, int h, int validFrom, f32x4 (&Sacc)[8], float& logD0, float& logD1, int tid, int lane, int w, float lb0, float lb1, float gn) {
    const int r = lane & 15, g = lane >> 4;
    {
        const unsigned (&F2)[8] = R.F2; const unsigned (&V2)[8] = R.V2; const unsigned (&Q2)[8] = R.Q2;
        float c0[8], c1[8], k0[8], k1[8]; float run0 = 1.f, run1 = 1.f;
#pragma unroll
        for (int i = 0; i < 8; ++i) { const bool valid = (8 * w + i) >= validFrom;
            const float f0 = lb0 + (1.f - lb0) * sigmoid_f(bflo(F2[i])), f1 = lb1 + (1.f - lb1) * sigmoid_f(bfhi(F2[i]));
            k0[i] = valid ? 1.f - f0 : 0.f; k1[i] = valid ? 1.f - f1 : 0.f;
            run0 *= valid ? f0 : 1.f; run1 *= valid ? f1 : 1.f; c0[i] = run0; c1[i] = run1; }
        *(LAS f32x2*)(lds + HG_PART + (w * 128 + 2 * lane) * 4) = (f32x2){run0, run1};
        LDS_WAIT(); __syncthreads();
        float off0 = 1.f, off1 = 1.f, tot0 = 1.f, tot1 = 1.f;
#pragma unroll
        for (int ww = 0; ww < 8; ++ww) { const f32x2 p = *(LAS f32x2*)(lds + HG_PART + (ww * 128 + 2 * lane) * 4); if (ww < w) { off0 *= p.x; off1 *= p.y; } tot0 *= p.x; tot1 *= p.y; }
        logD0 *= tot0; logD1 *= tot1;
        const float ebl0 = tot0, ebl1 = tot1;
        float kh0[8], kh1[8];
#pragma unroll
        for (int i = 0; i < 8; ++i) { const float e0 = off0 * c0[i], e1 = off1 * c1[i];
            const float kt0 = k0[i] * fast_rcp(e0), kt1 = k1[i] * fast_rcp(e1);
            kh0[i] = kt0 * ebl0; kh1[i] = kt1 * ebl1;
            if (FULL) { const int t = 8 * w + i;
                *(LAS unsigned*)(lds + HG_QT + t * 272 + 4 * lane) = cvt_pk_bf16(bflo(Q2[i]) * e0, bfhi(Q2[i]) * e1);
                *(LAS unsigned*)(lds + HG_KT + t * 272 + 4 * lane) = cvt_pk_bf16(kt0, kt1); } }
        { u32x4 a, b; a.x = cvt_pk_bf16(kh0[0], kh0[1]); a.y = cvt_pk_bf16(kh0[2], kh0[3]); a.z = cvt_pk_bf16(kh0[4], kh0[5]); a.w = cvt_pk_bf16(kh0[6], kh0[7]);
          b.x = cvt_pk_bf16(kh1[0], kh1[1]); b.y = cvt_pk_bf16(kh1[2], kh1[3]); b.z = cvt_pk_bf16(kh1[4], kh1[5]); b.w = cvt_pk_bf16(kh1[6], kh1[7]);
          *(LAS u32x4*)(lds + HG_KHT + (2 * lane) * 144 + 16 * w) = a; *(LAS u32x4*)(lds + HG_KHT + (2 * lane + 1) * 144 + 16 * w) = b; }
        { u32x4 a, b;
          a.x = (V2[0] & 0xffffu) | (V2[1] << 16); a.y = (V2[2] & 0xffffu) | (V2[3] << 16); a.z = (V2[4] & 0xffffu) | (V2[5] << 16); a.w = (V2[6] & 0xffffu) | (V2[7] << 16);
          b.x = (V2[0] >> 16) | (V2[1] & 0xffff0000u); b.y = (V2[2] >> 16) | (V2[3] & 0xffff0000u); b.z = (V2[4] >> 16) | (V2[5] & 0xffff0000u); b.w = (V2[6] >> 16) | (V2[7] & 0xffff0000u);
          *(LAS u32x4*)(lds + HG_VT + (2 * lane) * 144 + 16 * w) = a; *(LAS u32x4*)(lds + HG_VT + (2 * lane + 1) * 144 + 16 * w) = b; }
        if (w == 0) *(LAS f32x2*)(lds + HG_DV + 8 * lane) = (f32x2){ebl0, ebl1};
    }
    f32x4 oacc[4];
    if (FULL) {
#pragma unroll
        for (int i = 0; i < 8; ++i) { u32x2 pk; pk.x = cvt_pk_bf16(Sacc[i][0], Sacc[i][1]); pk.y = cvt_pk_bf16(Sacc[i][2], Sacc[i][3]);
            *(LAS u32x2*)(lds + HG_SW + w * 4352 + r * 272 + (16 * i + 4 * g) * 2) = pk; }
    }
    LDS_WAIT(); __syncthreads();
    if (FULL) {
#pragma unroll
        for (int rep = 0; rep < 2; ++rep) {
            const int id = rep == 0 ? w : 8 + w;
            if (rep == 1 && w >= 2) break;
            int tt, st;
            if (id == 0) { tt = 0; st = 0; } else if (id < 3) { tt = 1; st = id - 1; } else if (id < 6) { tt = 2; st = id - 3; } else { tt = 3; st = id - 6; }
            f32x4 acc = {0.f, 0.f, 0.f, 0.f};
#pragma unroll
            for (int ks = 0; ks < 4; ++ks) { const bf16x8 a = lds_b128(lds + HG_KT + (16 * st + r) * 272 + (32 * ks + 8 * g) * 2), b = lds_b128(lds + HG_QT + (16 * tt + r) * 272 + (32 * ks + 8 * g) * 2); acc = mfma16(a, b, acc); }
            asm volatile("s_nop 15" : "+v"(acc));
            if (st == tt) {
#pragma unroll
                for (int e = 0; e < 4; ++e) if (4 * g + e > r) acc[e] = 0.f; }
            u32x2 pk; pk.x = cvt_pk_bf16(acc[0], acc[1]); pk.y = cvt_pk_bf16(acc[2], acc[3]);
            *(LAS u32x2*)(lds + HG_PL + (16 * tt + r) * 144 + (16 * st + 4 * g) * 2) = pk;
        }
        LDS_WAIT(); __syncthreads();
#pragma unroll
        for (int tt = 0; tt < 4; ++tt) { f32x4 o = {0.f, 0.f, 0.f, 0.f};
#pragma unroll
            for (int ks = 0; ks < 4; ++ks) { const bf16x8 a = lds_b128(lds + HG_QT + (16 * tt + r) * 272 + (32 * ks + 8 * g) * 2), b = lds_b128(lds + HG_SW + w * 4352 + r * 272 + (32 * ks + 8 * g) * 2); o = mfma16(a, b, o); }
#pragma unroll
            for (int ks = 0; ks < 2; ++ks) { if (ks == 1 && tt < 2) break;
                const bf16x8 a = lds_b128(lds + HG_PL + (16 * tt + r) * 144 + (32 * ks + 8 * g) * 2), b = lds_b128(lds + HG_VT + (16 * w + r) * 144 + (32 * ks + 8 * g) * 2); o = mfma16(a, b, o); }
            oacc[tt] = o; }
    }
#pragma unroll
    for (int i = 0; i < 8; ++i) { const f32x4 dd = *(LAS f32x4*)(lds + HG_DV + (16 * i + 4 * g) * 4); f32x4 s = Sacc[i] * dd;
#pragma unroll
        for (int ks = 0; ks < 2; ++ks) { const bf16x8 a = lds_b128(lds + HG_KHT + (16 * i + r) * 144 + (32 * ks + 8 * g) * 2), b = lds_b128(lds + HG_VT + (16 * w + r) * 144 + (32 * ks + 8 * g) * 2); s = mfma16(a, b, s); }
        Sacc[i] = s; }
    if (FULL) {
#pragma unroll
        for (int tt = 0; tt < 4; ++tt)
#pragma unroll
            for (int e = 0; e < 4; ++e) { float ss = oacc[tt][e] * oacc[tt][e];
                ss += dpp_f(ss, 0xB1); ss += dpp_f(ss, 0x4E); ss += dpp_f(ss, 0x141); ss += dpp_f(ss, 0x140);
                if (r == 0) *(LAS float*)(lds + HG_P2 + ((16 * tt + 4 * g + e) * 8 + w) * 4) = ss; }
        LDS_WAIT(); __syncthreads();
#pragma unroll
        for (int tt = 0; tt < 4; ++tt)
#pragma unroll
            for (int e = 0; e < 4; ++e) { const int t = 16 * tt + 4 * g + e;
                const f32x4 pa = *(LAS f32x4*)(lds + HG_P2 + t * 32), pb = *(LAS f32x4*)(lds + HG_P2 + t * 32 + 16); const float ss = ((pa[0] + pa[1]) + (pa[2] + pa[3])) + ((pb[0] + pb[1]) + (pb[2] + pb[3]));
                const float v = oacc[tt][e] * (__builtin_amdgcn_rsqf(ss * (1.f / 128.f) + EPS)) * gn;
                *(LAS unsigned short*)(lds + HG_OT + t * 272 + (16 * w + r) * 2) = (unsigned short)(cvt_pk_bf16(v, 0.f) & 0xffffu); }
        LDS_WAIT(); __syncthreads();
        { const int t = tid >> 3;
#pragma unroll
          for (int j = 0; j < 2; ++j) { const int ch = (tid & 7) * 2 + j; *(u32x4*)(A.OR_ + (row0 + t) * 1024 + (size_t)h * 128 + ch * 8) = *(LAS u32x4*)(lds + HG_OT + t * 272 + ch * 16); } }
    } else { LDS_WAIT(); __syncthreads(); }
}
__device__ __forceinline__ void hg_unit_ids(int u, int& b, int& h, int& seg) { b = u >> 6; h = (u >> 3) & 7; seg = u & 7; }
__device__ __forceinline__ void h1_unit(const Frame& F, const HgArgs& A) {
    int b, h, seg; hg_unit_ids(F.vcu, b, h, seg);
    f32x4 Sacc[8];
#pragma unroll
    for (int i = 0; i < 8; ++i) Sacc[i] = (f32x4){0.f, 0.f, 0.f, 0.f};
    float ld0 = 1.f, ld1 = 1.f;
    const size_t rbase = (size_t)b * SEQ + (size_t)(16 * seg) * 64;
    const float lb0 = A.LB[h * 128 + 2 * F.lane], lb1 = A.LB[h * 128 + 2 * F.lane + 1], gn = A.RNG[16 * F.wave + (F.lane & 15)];
    HgRegs Ra, Rb;
    if (seg == 0) { hg_load<false>(Ra, A, (size_t)NTOK, h, F.lane, F.wave); hg_load<false>(Rb, A, rbase, h, F.lane, F.wave); hg_chunk<false>(F.lds, A, Ra, (size_t)NTOK, h, 48, Sacc, ld0, ld1, F.tid, F.lane, F.wave, lb0, lb1, gn); }
    else hg_load<false>(Rb, A, rbase, h, F.lane, F.wave);
    for (int c = 0; c < 16; c += 2) {
        hg_load<false>(Ra, A, rbase + (size_t)(c + 1) * 64, h, F.lane, F.wave);
        hg_chunk<false>(F.lds, A, Rb, rbase + (size_t)c * 64, h, 0, Sacc, ld0, ld1, F.tid, F.lane, F.wave, lb0, lb1, gn);
        hg_load<false>(Rb, A, rbase + (size_t)(c + 2 < 16 ? c + 2 : 15) * 64, h, F.lane, F.wave);
        hg_chunk<false>(F.lds, A, Ra, rbase + (size_t)(c + 1) * 64, h, 0, Sacc, ld0, ld1, F.tid, F.lane, F.wave, lb0, lb1, gn);
    }
    float* sl = A.SLOC + (size_t)F.vcu * 16384 + F.wave * 2048 + F.lane;
#pragma unroll
    for (int i = 0; i < 8; ++i)
#pragma unroll
        for (int e = 0; e < 4; ++e) sl[(i * 4 + e) * 64] = Sacc[i][e];
    if (F.wave == 0) { A.DSEG[F.vcu * 128 + 2 * F.lane] = ld0; A.DSEG[F.vcu * 128 + 2 * F.lane + 1] = ld1; }
}
__device__ __forceinline__ void h3_unit(const Frame& F, const HgArgs& A) {
    int b, h, seg; hg_unit_ids(F.vcu, b, h, seg);
    const int g = F.lane >> 4;
    f32x4 Sacc[8];
#pragma unroll
    for (int i = 0; i < 8; ++i) Sacc[i] = (f32x4){0.f, 0.f, 0.f, 0.f};
    for (int j = 0; j < seg; j += 2) {
        const bool two = j + 1 < seg; const int ua = (F.vcu & ~7) + j, ub = two ? ua + 1 : ua;
        const float* sa = A.SLOC + (size_t)ua * 16384 + F.wave * 2048 + F.lane; const float* da = A.DSEG + ua * 128;
        const float* sb = A.SLOC + (size_t)ub * 16384 + F.wave * 2048 + F.lane; const float* db = A.DSEG + ub * 128;
        f32x4 dda[8], ddb[8]; float la[32], lb[32];
#pragma unroll
        for (int i = 0; i < 8; ++i) { dda[i] = *(const f32x4*)(da + 16 * i + 4 * g); ddb[i] = *(const f32x4*)(db + 16 * i + 4 * g);
#pragma unroll
            for (int e = 0; e < 4; ++e) { la[i * 4 + e] = sa[(i * 4 + e) * 64]; lb[i * 4 + e] = sb[(i * 4 + e) * 64]; } }
#pragma unroll
        for (int i = 0; i < 8; ++i)
#pragma unroll
            for (int e = 0; e < 4; ++e) { const float s1 = Sacc[i][e] * dda[i][e] + la[i * 4 + e]; Sacc[i][e] = two ? s1 * ddb[i][e] + lb[i * 4 + e] : s1; } }
    for (int i = F.tid; i < 64 * 36; i += NWAVES * 64) *(LAS unsigned*)(F.lds + HG_PL + i * 4) = 0u;
    LDS_WAIT(); __syncthreads();
    float ld0 = 1.f, ld1 = 1.f;
    const size_t rbase = (size_t)b * SEQ + (size_t)(16 * seg) * 64;
    const float lb0 = A.LB[h * 128 + 2 * F.lane], lb1 = A.LB[h * 128 + 2 * F.lane + 1], gn = A.RNG[16 * F.wave + (F.lane & 15)];
    HgRegs Ra, Rb;
    if (seg == 0) { hg_load<false>(Ra, A, (size_t)NTOK, h, F.lane, F.wave); hg_load<true>(Rb, A, rbase, h, F.lane, F.wave); hg_chunk<false>(F.lds, A, Ra, (size_t)NTOK, h, 48, Sacc, ld0, ld1, F.tid, F.lane, F.wave, lb0, lb1, gn); }
    else hg_load<true>(Rb, A, rbase, h, F.lane, F.wave);
    for (int c = 0; c < 16; c += 2) {
        hg_load<true>(Ra, A, rbase + (size_t)(c + 1) * 64, h, F.lane, F.wave);
        hg_chunk<true>(F.lds, A, Rb, rbase + (size_t)c * 64, h, 0, Sacc, ld0, ld1, F.tid, F.lane, F.wave, lb0, lb1, gn);
        hg_load<true>(Rb, A, rbase + (size_t)(c + 2 < 16 ? c + 2 : 15) * 64, h, F.lane, F.wave);
        hg_chunk<true>(F.lds, A, Ra, rbase + (size_t)(c + 1) * 64, h, 0, Sacc, ld0, ld1, F.tid, F.lane, F.wave, lb0, lb1, gn);
    }
}

struct KnArgs { const bf16_t *AK, *AV; const float* GK; unsigned char *KN, *VV; };
__device__ __forceinline__ void knorm_share(const Frame& F, const KnArgs& A) {
    const int gw = F.vcu * NWAVES + F.wave, NGW = F.G * NWAVES, sub = F.lane >> 4, part = F.lane & 15;
    const f32x4 g0 = *(const f32x4*)(A.GK + 8 * part), g1 = *(const f32x4*)(A.GK + 8 * part + 4);
    constexpr int KB = 4;
    for (int vb0 = gw * 4; vb0 < NB * 2 * NKEY; vb0 += KB * NGW * 4) {
        u32x4 kk[KB], vv[KB];
#pragma unroll
        for (int q = 0; q < KB; ++q) { const int v0 = vb0 + q * NGW * 4; const int v = (v0 < NB * 2 * NKEY ? v0 : vb0) + sub;
            const int b = v / (2 * NKEY), rem = v % (2 * NKEY), kvh = rem / NKEY, j = rem % NKEY;
            const size_t srow = j < 16 ? (size_t)(META_ROW0 + j) : (size_t)b * SEQ + (j - 16);
            kk[q] = *(const u32x4*)(A.AK + srow * 256 + kvh * 128 + 8 * part); vv[q] = *(const u32x4*)(A.AV + srow * 256 + kvh * 128 + 8 * part); }
#pragma unroll
        for (int q = 0; q < KB; ++q) { const int v0 = vb0 + q * NGW * 4; if (v0 >= NB * 2 * NKEY) continue;
            const int v = v0 + sub;
            const float x0 = bflo(kk[q].x), x1 = bfhi(kk[q].x), x2 = bflo(kk[q].y), x3 = bfhi(kk[q].y), x4 = bflo(kk[q].z), x5 = bfhi(kk[q].z), x6 = bflo(kk[q].w), x7 = bfhi(kk[q].w);
            float ss = ((x0 * x0 + x1 * x1) + (x2 * x2 + x3 * x3)) + ((x4 * x4 + x5 * x5) + (x6 * x6 + x7 * x7));
            ss += __shfl_xor(ss, 1); ss += __shfl_xor(ss, 2); ss += __shfl_xor(ss, 4); ss += __shfl_xor(ss, 8);
            const float rstd = __builtin_amdgcn_rsqf(ss * (1.f / 128.f) + EPS);
            int k0 = __builtin_amdgcn_cvt_pk_fp8_f32(x0 * rstd * g0[0], x1 * rstd * g0[1], 0, false); k0 = __builtin_amdgcn_cvt_pk_fp8_f32(x2 * rstd * g0[2], x3 * rstd * g0[3], k0, true);
            int k1 = __builtin_amdgcn_cvt_pk_fp8_f32(x4 * rstd * g1[0], x5 * rstd * g1[1], 0, false); k1 = __builtin_amdgcn_cvt_pk_fp8_f32(x6 * rstd * g1[2], x7 * rstd * g1[3], k1, true);
            int w0 = __builtin_amdgcn_cvt_pk_fp8_f32(bflo(vv[q].x), bfhi(vv[q].x), 0, false); w0 = __builtin_amdgcn_cvt_pk_fp8_f32(bflo(vv[q].y), bfhi(vv[q].y), w0, true);
            int w1 = __builtin_amdgcn_cvt_pk_fp8_f32(bflo(vv[q].z), bfhi(vv[q].z), 0, false); w1 = __builtin_amdgcn_cvt_pk_fp8_f32(bflo(vv[q].w), bfhi(vv[q].w), w1, true);
            *(u32x2*)(A.KN + (size_t)v * 128 + 8 * part) = (u32x2){(unsigned)k0, (unsigned)k1};
            *(u32x2*)(A.VV + (size_t)v * 128 + 8 * part) = (u32x2){(unsigned)w0, (unsigned)w1}; }
    }
}

constexpr int IX_HIST = 0, IX_CAND = 8192, CB_CAP = 704, IX_QB = CB_CAP * 6, IX_END = IX_CAND + 8 * 4 * IX_QB;
struct IxArgs { const bf16_t *IQ, *IKC; const float* IW; unsigned short* IDX; int* CNT; };

__device__ __forceinline__ unsigned sortable_key(unsigned bits) { return bits ^ ((bits >> 31) ? 0xffffffffu : 0x80000000u); }
__device__ __forceinline__ float key_to_float(unsigned k) { return __uint_as_float((k & 0x80000000u) ? (k ^ 0x80000000u) : ~k); }
__device__ __forceinline__ float vmax0(float a) { float r; asm("v_max_f32_e32 %0, 0, %1" : "=v"(r) : "v"(a)); return r; }
__device__ __forceinline__ float vfma(float a, float b, float c) { float r; asm("v_fma_f32 %0, %1, %2, %3" : "=v"(r) : "v"(a), "v"(b), "v"(c)); return r; }

__device__ __forceinline__ void radix_scan(LAS unsigned* hist, int lane, unsigned need, unsigned& bin, unsigned& above, unsigned& cbin) {
    const u32x4 c = *(LAS u32x4*)(hist + 4 * lane);
    const unsigned tot = c.x + c.y + c.z + c.w; unsigned inc = tot;
    inc += (unsigned)__builtin_amdgcn_update_dpp(0, (int)inc, 0x111, 0xf, 0xf, false);
    inc += (unsigned)__builtin_amdgcn_update_dpp(0, (int)inc, 0x112, 0xf, 0xf, false);
    inc += (unsigned)__builtin_amdgcn_update_dpp(0, (int)inc, 0x114, 0xf, 0xf, false);
    inc += (unsigned)__builtin_amdgcn_update_dpp(0, (int)inc, 0x118, 0xf, 0xf, false);
    { const unsigned t0 = (unsigned)__builtin_amdgcn_readlane((int)inc, 15), t1 = (unsigned)__builtin_amdgcn_readlane((int)inc, 31), t2 = (unsigned)__builtin_amdgcn_readlane((int)inc, 47);
      const int row = lane >> 4; inc += (row >= 1 ? t0 : 0u) + (row >= 2 ? t1 : 0u) + (row >= 3 ? t2 : 0u); }
    const unsigned total = (unsigned)__builtin_amdgcn_readlane((int)inc, 63);
    const unsigned a3 = total - inc, a2 = a3 + c.w, a1 = a2 + c.z, a0 = a1 + c.y;
    int fb = -1; unsigned fa = 0, fc = 0;
    if (a3 < need && need <= a3 + c.w) { fb = 4 * lane + 3; fa = a3; fc = c.w; }
    else if (a2 < need && need <= a2 + c.z) { fb = 4 * lane + 2; fa = a2; fc = c.z; }
    else if (a1 < need && need <= a1 + c.y) { fb = 4 * lane + 1; fa = a1; fc = c.y; }
    else if (a0 < need && need <= a0 + c.x) { fb = 4 * lane; fa = a0; fc = c.x; }
    const unsigned long long bm = __ballot(fb >= 0);
    const int src = bm ? __builtin_ctzll(bm) : 0;
    bin = (unsigned)__builtin_amdgcn_readlane(fb, src); above = (unsigned)__builtin_amdgcn_readlane((int)fa, src); cbin = (unsigned)__builtin_amdgcn_readlane((int)fc, src);
}
template <int NE = CB_CAP / 64>
__device__ __forceinline__ float topk_select(LAS unsigned char* qb, int n, LAS unsigned* hist, int lane, unsigned short* idx_out, int& kept, unsigned need0 = 256u) {
    asm volatile("" ::: "memory");
    unsigned key[NE], ix[NE]; unsigned vmask = 0;
#pragma unroll
    for (int i = 0; i < NE; ++i) { const int e = lane + 64 * i; key[i] = 0; ix[i] = 0;
        if (e < n) { key[i] = sortable_key(*(LAS unsigned*)(qb + 4 * e)); ix[i] = *(LAS unsigned short*)(qb + 4 * CB_CAP + 2 * e); vmask |= 1u << i; } }
    unsigned kmask = 0, kval = 0, need = need0; int pass0 = 0;
    { const unsigned d0 = (unsigned)__builtin_amdgcn_readfirstlane((int)(key[0] >> 24)); bool diff = false;
#pragma unroll
      for (int i = 0; i < NE; ++i) diff |= ((vmask >> i) & 1u) && (key[i] >> 24) != d0;
      if (__ballot(diff) == 0ull) { kval = d0 << 24; kmask = 0xff000000u; pass0 = 1; } }
    const int npass = idx_out ? 3 : 2;
    unsigned above_tot = 0; bool whole = false;
#pragma unroll 1
    for (int pass = pass0; pass < npass; ++pass) { const int shift = 24 - 8 * pass;
        *(LAS u32x4*)(hist + 4 * lane) = (u32x4){0u, 0u, 0u, 0u};
        if (pass == 0) {
            const unsigned d0 = key[0] >> 24; unsigned c0 = 0;
#pragma unroll
            for (int i = 0; i < NE; ++i) if ((vmask >> i) & 1u) { const unsigned d = key[i] >> 24; if (d == d0) ++c0; else __hip_atomic_fetch_add(hist + d, 1u, __ATOMIC_RELAXED, __HIP_MEMORY_SCOPE_WORKGROUP); }
            if (vmask & 1u) __hip_atomic_fetch_add(hist + d0, c0, __ATOMIC_RELAXED, __HIP_MEMORY_SCOPE_WORKGROUP);
        } else {
#pragma unroll
            for (int i = 0; i < NE; ++i) if (((vmask >> i) & 1u) && (key[i] & kmask) == kval) __hip_atomic_fetch_add(hist + ((key[i] >> shift) & 255u), 1u, __ATOMIC_RELAXED, __HIP_MEMORY_SCOPE_WORKGROUP);
        }
        LDS_WAIT();
        unsigned bin, above, cbin; radix_scan(hist, lane, need, bin, above, cbin);
        kval |= bin << shift; kmask |= 255u << shift; need -= above; above_tot += above;
        if (cbin == need) { whole = true; break; }
        if (pass == npass - 1 && !idx_out) { if (above_tot + cbin <= CB_CAP - 192) { need = cbin; whole = true; } }
    }
    unsigned base = 0, bbin = 0;
    if (whole) {
#pragma unroll
        for (int i = 0; i < NE; ++i) { const bool sel = ((vmask >> i) & 1u) && (key[i] & kmask) >= kval;
            const unsigned long long bm = __ballot(sel);
            const unsigned pos = base + __builtin_amdgcn_mbcnt_hi((unsigned)(bm >> 32), __builtin_amdgcn_mbcnt_lo((unsigned)bm, 0u));
            if (sel && (pos < 256 || !idx_out)) {
                if (idx_out) idx_out[pos] = (unsigned short)ix[i];
                else { const unsigned kk = key[i]; *(LAS unsigned*)(qb + 4 * pos) = (kk & 0x80000000u) ? (kk ^ 0x80000000u) : ~kk; *(LAS unsigned short*)(qb + 4 * CB_CAP + 2 * pos) = (unsigned short)ix[i]; } }
            base += (unsigned)__builtin_popcountll(bm); }
    } else
#pragma unroll
    for (int i = 0; i < NE; ++i) { const unsigned km = key[i] & kmask; const bool v = (vmask >> i) & 1u;
        const bool inb = v && km == kval;
        const unsigned long long bi = __ballot(inb);
        const unsigned rk = bbin + __builtin_amdgcn_mbcnt_hi((unsigned)(bi >> 32), __builtin_amdgcn_mbcnt_lo((unsigned)bi, 0u));
        bbin += (unsigned)__builtin_popcountll(bi);
        const bool sel = (v && km > kval) || (inb && rk < need);
        const unsigned long long bm = __ballot(sel);
        const unsigned pos = base + __builtin_amdgcn_mbcnt_hi((unsigned)(bm >> 32), __builtin_amdgcn_mbcnt_lo((unsigned)bm, 0u));
        if (sel && (pos < 256 || !idx_out)) {
            if (idx_out) idx_out[pos] = (unsigned short)ix[i];
            else { const unsigned kk = key[i]; *(LAS unsigned*)(qb + 4 * pos) = (kk & 0x80000000u) ? (kk ^ 0x80000000u) : ~kk; *(LAS unsigned short*)(qb + 4 * CB_CAP + 2 * pos) = (unsigned short)ix[i]; } }
        base += (unsigned)__builtin_popcountll(bm); }
    LDS_WAIT();
    kept = (int)base;
    return key_to_float(kval);
}

typedef float f32x16 __attribute__((ext_vector_type(16)));
__device__ __forceinline__ void ix_bload(const bf16_t* sub, int lane, bf16x8 (&bf)[4]) {
#pragma unroll
    for (int ks = 0; ks < 4; ++ks) bf[ks] = *(const bf16x8*)(sub + (ks * 64 + lane) * 8);
}
__device__ __forceinline__ f32x16 ix_mma(const bf16x8 (&af)[4], const bf16x8 (&bf)[4]) {
    f32x16 acc = {};
#pragma unroll
    for (int ks = 0; ks < 4; ++ks) acc = __builtin_amdgcn_mfma_f32_32x32x16_bf16(af[ks], bf[ks], acc, 0, 0, 0);
    return acc;
}
__device__ __forceinline__ void ix_unit(const Frame& F, const IxArgs& A, int b, int qg) {
    const int lane = F.lane, w = F.wave, rho = lane & 31, hf = lane >> 5;
    const int t0 = 32 * qg + 4 * w;
    const int qq = 2 * ((rho >> 2) & 1) + (rho >> 4), hh = 4 * ((rho >> 3) & 1) + (rho & 3);
    bf16x8 af[4];
    { const bf16_t* p = A.IQ + ((size_t)b * SEQ + t0 + qq) * 512 + hh * 64 + 8 * hf;
#pragma unroll
      for (int ks = 0; ks < 4; ++ks) af[ks] = *(const bf16x8*)(p + 16 * ks); }
    float wv[2][8];
#pragma unroll
    for (int a = 0; a < 2; ++a) { const float* p = A.IW + ((size_t)b * SEQ + t0 + 2 * hf + a) * 8; const f32x4 x = *(const f32x4*)p, y = *(const f32x4*)(p + 4);
        wv[a][0] = x[0]; wv[a][1] = x[1]; wv[a][2] = x[2]; wv[a][3] = x[3]; wv[a][4] = y[0]; wv[a][5] = y[1]; wv[a][6] = y[2]; wv[a][7] = y[3]; }
    float tau0 = -INFINITY, tau1 = -INFINITY; int cnt0 = 0, cnt1 = 0; bool est = true;
    const int lim0 = 16 + t0 + 2 * hf, lim1 = lim0 + 1;
    const int nsub = ((16 + t0 + 3) >> 5) + 1;
    LAS unsigned char* candw = F.lds + IX_CAND + w * 4 * IX_QB;
    LAS unsigned char* cb0 = candw + (2 * hf) * IX_QB; LAS unsigned char* cb1 = cb0 + IX_QB;
    LAS unsigned* hist = (LAS unsigned*)(F.lds + IX_HIST + w * 1024);
    const bf16_t* ikc_b = A.IKC + (size_t)b * IKC_SUBS * 2048;
#define IX_PROCESS(cur, k_) do { \
        float sc0 = 0.f, sc1 = 0.f; \
        _Pragma("unroll") for (int c = 0; c < 8; ++c) { sc0 = vfma(vmax0(cur[c]), wv[0][c], sc0); sc1 = vfma(vmax0(cur[8 + c]), wv[1][c], sc1); } \
        const int j = 32 * (k_) + rho; \
        const bool p0 = (sc0 > tau0) && (j <= lim0), p1 = (sc1 > tau1) && (j <= lim1); \
        const unsigned long long m0 = __ballot(p0), m1 = __ballot(p1); \
        if ((m0 | m1) != 0ull) { \
            const unsigned lm = (1u << rho) - 1u; \
            { const unsigned mine = hf ? (unsigned)(m0 >> 32) : (unsigned)m0; const int pos = cnt0 + __popc(mine & lm); \
              if (p0) { *(LAS unsigned*)(cb0 + 4 * pos) = __float_as_uint(sc0); *(LAS unsigned short*)(cb0 + 4 * CB_CAP + 2 * pos) = (unsigned short)j; } cnt0 += __popc(mine); } \
            { const unsigned mine = hf ? (unsigned)(m1 >> 32) : (unsigned)m1; const int pos = cnt1 + __popc(mine & lm); \
              if (p1) { *(LAS unsigned*)(cb1 + 4 * pos) = __float_as_uint(sc1); *(LAS unsigned short*)(cb1 + 4 * CB_CAP + 2 * pos) = (unsigned short)j; } cnt1 += __popc(mine); } \
              \
            if (__ballot(cnt0 > CB_CAP - 32 || cnt1 > CB_CAP - 32) != 0ull) { \
                _Pragma("unroll 1") for (int q = 0; q < 4; ++q) { const int qc = __builtin_amdgcn_readlane((q & 1) ? cnt1 : cnt0, (q >> 1) * 32); \
                    if (qc > CB_CAP - 32) { int kept_; unsigned need_ = 256u; \
                        if (est && __builtin_amdgcn_readlane(__float_as_int((q & 1) ? tau1 : tau0), (q >> 1) * 32) == (int)0xff800000) {     \
                            const unsigned r_ = (unsigned)((512 * qc) / (17 + t0 + q)) + 1u; need_ = r_ < 256u ? (r_ < 24u ? 24u : r_) : 256u; } \
                        const float nt = topk_select(candw + q * IX_QB, qc, hist, lane, nullptr, kept_, need_); \
                        if (hf == (q >> 1)) { if (q & 1) { tau1 = nt; cnt1 = kept_; } else { tau0 = nt; cnt0 = kept_; } } } } } \
        } } while (0)
#pragma unroll 1
    for (int attempt = 0; attempt < 2; ++attempt) {
    tau0 = -INFINITY; tau1 = -INFINITY; cnt0 = 0; cnt1 = 0;
    bf16x8 bA[4], bB[4]; f32x16 accA, accB;
    const unsigned char* ikc_l = (const unsigned char*)ikc_b + 16 * lane; const int slast = nsub - 1;
    ix_bload(ikc_b, lane, bA); ix_bload(ikc_b + (size_t)(slast < 1 ? slast : 1) * 2048, lane, bB);
    accA = ix_mma(af, bA); accB = ix_mma(af, bB);
    asm volatile("s_nop 15\n\ts_nop 7" : "+v"(accA), "+v"(accB));
#define IX_GLD4(B, sidx) do { const unsigned char* p_ = ikc_l + (size_t)((sidx) < slast ? (sidx) : slast) * 4096; \
        asm volatile("global_load_dwordx4 %0, %4, off\n\tglobal_load_dwordx4 %1, %4, off offset:1024\n\tglobal_load_dwordx4 %2, %4, off offset:2048\n\tglobal_load_dwordx4 %3, %4, off offset:3072" \
                     : "=&v"(B[0]), "=&v"(B[1]), "=&v"(B[2]), "=&v"(B[3]) : "v"(p_) : "memory"); } while (0)
#pragma unroll 1
    for (int k = 0; k < nsub; k += 2) {
        bf16x8 nA[4], nB[4];
        IX_GLD4(nA, k + 2); IX_GLD4(nB, k + 3);
        IX_PROCESS(accA, k);
        if (k + 1 < nsub) IX_PROCESS(accB, k + 1);
        asm volatile("s_waitcnt vmcnt(0)" : "+v"(nA[0]), "+v"(nA[1]), "+v"(nA[2]), "+v"(nA[3]), "+v"(nB[0]), "+v"(nB[1]), "+v"(nB[2]), "+v"(nB[3]) :: "memory");
        accA = ix_mma(af, nA); accB = ix_mma(af, nB);
        asm volatile("s_nop 15\n\ts_nop 7" : "+v"(accA), "+v"(accB));
    }
    { int short_ = 0;
#pragma unroll
      for (int q = 0; q < 4; ++q) { const int n_ = __builtin_amdgcn_readlane((q & 1) ? cnt1 : cnt0, (q >> 1) * 32), nt_ = 17 + t0 + q; short_ |= (n_ < (nt_ < 256 ? nt_ : 256)) ? 1 : 0; }
      if (!short_) break;
      est = false; }
    }
#undef IX_GLD4
#undef IX_PROCESS
#pragma unroll 1
    for (int q = 0; q < 4; ++q) { const size_t row = (size_t)b * SEQ + t0 + q; unsigned short* io = A.IDX + row * 256; const int n = __builtin_amdgcn_readlane((q & 1) ? cnt1 : cnt0, (q >> 1) * 32);
        LAS unsigned char* qb = candw + q * IX_QB;
        if (n > 256) { int k_; if (n <= 576) (void)topk_select<9>(qb, n, hist, lane, io, k_); else (void)topk_select<CB_CAP / 64>(qb, n, hist, lane, io, k_); if (lane == 0) A.CNT[row] = 256; }
        else {
#pragma unroll
            for (int i = 0; i < 4; ++i) { const int e = lane + 64 * i; io[e] = e < n ? *(LAS unsigned short*)(qb + 4 * CB_CAP + 2 * e) : (unsigned short)0; }
            if (lane == 0) A.CNT[row] = n; } }
    LDS_WAIT();
}

constexpr int AT_VB = 0, AT_IDX = 131072, AT_END = 131072 + 8 * 512;
static_assert(AT_END <= LDSCTL_OFF && IX_END <= LDSCTL_OFF, "LDS maps");
struct AtArgs { const bf16_t* AQ; const unsigned char *KN, *VV; bf16_t* OA; const unsigned short* IDX; const int* CNT; const float* GQ; bf16_t* DUMMY; };
typedef __bf16 bf16x2_t __attribute__((ext_vector_type(2)));
__device__ __forceinline__ bf16x8 fp8x8_to_bf16(unsigned d0, unsigned d1) {
    u32x4 o; o.x = __builtin_bit_cast(unsigned, __builtin_amdgcn_cvt_scalef32_pk_bf16_fp8(d0, 1.0f, false)); o.y = __builtin_bit_cast(unsigned, __builtin_amdgcn_cvt_scalef32_pk_bf16_fp8(d0, 1.0f, true));
    o.z = __builtin_bit_cast(unsigned, __builtin_amdgcn_cvt_scalef32_pk_bf16_fp8(d1, 1.0f, false)); o.w = __builtin_bit_cast(unsigned, __builtin_amdgcn_cvt_scalef32_pk_bf16_fp8(d1, 1.0f, true));
    return __builtin_bit_cast(bf16x8, o);
}
__device__ __forceinline__ int vswz(int rho) { return ((rho & 3) | (((rho >> 3) & 1) << 2)) << 1; }
__device__ __forceinline__ s16x4 tr_read(LAS unsigned char* p) { typedef short v4i16 __attribute__((ext_vector_type(4))); return __builtin_bit_cast(s16x4, __builtin_amdgcn_ds_read_tr16_b64_v4i16((LAS v4i16*)p)); }

struct AtPre { u32x2 idxv; int n; u32x4 qraw[4]; };
__device__ __forceinline__ void at_preload(AtPre& P, const AtArgs& A, int b, int kvh, int t, int lane) {
    const size_t row = (size_t)b * SEQ + t; const int g = lane >> 4, hd = lane & 3;
    P.n = A.CNT[row]; P.idxv = *(const u32x2*)(A.IDX + row * 256 + 4 * lane);
    const bf16_t* qp = A.AQ + row * 1024 + (size_t)(4 * kvh + hd) * 128 + 32 * g;
#pragma unroll
    for (int ks = 0; ks < 4; ++ks) P.qraw[ks] = *(const u32x4*)(qp + 8 * ks);
}
__device__ __forceinline__ void at_query(const AtArgs& A, const AtPre& P, AtPre& PN, bool has_next, int t_next, int kvh_next, LAS unsigned char* vb, LAS unsigned char* idxl, int b, int kvh, int t, int lane) {
    const int r = lane & 15, g = lane >> 4, hd = lane & 3;
    const size_t row = (size_t)b * SEQ + t;
    const int n = P.n;
    *(LAS u32x2*)(idxl + 8 * lane) = P.idxv;
    if (has_next) at_preload(PN, A, b, kvh_next, t_next, lane);
    long qf[4]; float ssq = 0.f;
    { const float* gp = A.GQ + 32 * g;
#pragma unroll
      for (int ks = 0; ks < 4; ++ks) { const u32x4 raw = P.qraw[ks]; const f32x4 g0 = *(const f32x4*)(gp + 8 * ks), g1 = *(const f32x4*)(gp + 8 * ks + 4);
          const float x0 = bflo(raw.x), x1 = bfhi(raw.x), x2 = bflo(raw.y), x3 = bfhi(raw.y), x4 = bflo(raw.z), x5 = bfhi(raw.z), x6 = bflo(raw.w), x7 = bfhi(raw.w);
          ssq += (x0 * x0 + x1 * x1) + (x2 * x2 + x3 * x3) + (x4 * x4 + x5 * x5) + (x6 * x6 + x7 * x7);
          const unsigned lo = pack4_fp8(x0 * g0[0], x1 * g0[1], x2 * g0[2], x3 * g0[3]), hi = pack4_fp8(x4 * g1[0], x5 * g1[1], x6 * g1[2], x7 * g1[3]);
          qf[ks] = (long)(((unsigned long long)hi << 32) | lo); } }
    ssq += __shfl_xor(ssq, 16); ssq += __shfl_xor(ssq, 32);
    const float qs = (__builtin_amdgcn_rsqf(ssq * (1.f / 128.f) + EPS)) * (0.08838834764831845f * LOG2E);
    const float slope2 = __builtin_amdgcn_exp2f(-(float)(4 * kvh + hd + 1)) * LOG2E;
    const unsigned char* vbase = A.VV + (size_t)(b * 2 + kvh) * NKEY * 128;
    LDS_WAIT();
    f32x4 sc[16];
    unsigned idx_r = (unsigned)(uintptr_t)idxl + 2 * r, idx_g = (unsigned)(uintptr_t)idxl + 8 * g;
    asm volatile("" : "+v"(idx_r), "+v"(idx_g));
    {
        u32x4 kr[8][2];
        const int krl = lane >> 3, kch = lane & 7;
        unsigned idx_k = (unsigned)(uintptr_t)idxl + 4 * krl; asm volatile("" : "+v"(idx_k));
        const unsigned char* kb0 = A.KN + (size_t)(b * 2 + kvh) * NKEY * 128 + 16 * kch;
        unsigned kw0 = (unsigned)(uintptr_t)vb + 8192 + (2 * krl) * 128 + 16 * (kch ^ krl);
        unsigned kw1 = kw0 + 128;
        unsigned kr0 = (unsigned)(uintptr_t)vb + 8192 + r * 128 + 16 * ((2 * g) ^ ((r >> 1) & 7));
        asm volatile("" : "+v"(kw0), "+v"(kw1), "+v"(kr0));
#define AT_KLOAD(dst, i) do { const unsigned iab_ = *(LAS unsigned*)(uintptr_t)(idx_k + 32 * (i)), ia_ = iab_ & 0xffffu, ib_ = iab_ >> 16; \
            dst[0] = *(const u32x4*)(kb0 + (size_t)ia_ * 128); dst[1] = *(const u32x4*)(kb0 + (size_t)ib_ * 128); } while (0)
#define AT_KMMA(i) do { const u32x4 f0_ = *(LAS u32x4*)(uintptr_t)(kr0 + ((i) & 3) * 2048), f1_ = *(LAS u32x4*)(uintptr_t)((kr0 ^ 16) + ((i) & 3) * 2048); f32x4 acc = {0.f, 0.f, 0.f, 0.f}; \
            acc = __builtin_amdgcn_mfma_f32_16x16x32_fp8_fp8((long)(((unsigned long long)f0_.y << 32) | f0_.x), qf[0], acc, 0, 0, 0); \
            acc = __builtin_amdgcn_mfma_f32_16x16x32_fp8_fp8((long)(((unsigned long long)f0_.w << 32) | f0_.z), qf[1], acc, 0, 0, 0); \
            acc = __builtin_amdgcn_mfma_f32_16x16x32_fp8_fp8((long)(((unsigned long long)f1_.y << 32) | f1_.x), qf[2], acc, 0, 0, 0); \
            acc = __builtin_amdgcn_mfma_f32_16x16x32_fp8_fp8((long)(((unsigned long long)f1_.w << 32) | f1_.z), qf[3], acc, 0, 0, 0); sc[i] = acc; } while (0)
#pragma unroll
        for (int i = 0; i < 8; ++i) AT_KLOAD(kr[i], i);
#pragma unroll
        for (int i = 0; i < 16; ++i) {
            *(LAS u32x4*)(uintptr_t)(kw0 + (i & 3) * 2048) = kr[i & 7][0]; *(LAS u32x4*)(uintptr_t)(kw1 + (i & 3) * 2048) = kr[i & 7][1];
            if (i + 8 < 16) AT_KLOAD(kr[i & 7], i + 8);
            if (i >= 1) AT_KMMA(i - 1); }
        AT_KMMA(15);
#undef AT_KLOAD
#undef AT_KMMA
    }
    __builtin_amdgcn_sched_barrier(0);
    const int vrl = lane >> 3, vch = lane & 7;
    u32x4 vd[3][4];
    unsigned idx_v = (unsigned)(uintptr_t)idxl; asm volatile("" : "+v"(idx_v));
    unsigned vsl[4];
#pragma unroll
    for (int c4 = 0; c4 < 4; ++c4) { const int rho = 8 * c4 + vrl; vsl[c4] = 2u * (unsigned)(16 * ((rho & 7) >> 2) + 4 * (rho >> 3) + (rho & 3)); }
#define AT_VLOAD(dst, kk) do { _Pragma("unroll") for (int c4 = 0; c4 < 4; ++c4) { const unsigned iv_ = *(LAS unsigned short*)(uintptr_t)(idx_v + 64 * (kk) + vsl[c4]); \
        dst[c4] = *(const u32x4*)(vbase + (size_t)iv_ * 128 + 16 * vch); } } while (0)
    AT_VLOAD(vd[0], 7); AT_VLOAD(vd[1], 6); AT_VLOAD(vd[2], 5);
    const int rep = (lane >> 2) & 3;
    float mx = -INFINITY; const float qpos = (float)(16 + t); int nrel = n - 4 * g - 16 * rep; asm volatile("" : "+v"(nrel));
    unsigned idx_gr = idx_g + 32 * rep; asm volatile("" : "+v"(idx_gr));
    float yv[4][4];
    { const bool m1 = rep == 1, m2 = rep == 2, m3 = rep == 3;
#pragma unroll
      for (int j = 0; j < 4; ++j) { const u32x2 iv = *(LAS u32x2*)(uintptr_t)(idx_gr + 128 * j);
        float s0 = sc[4 * j][0], s1 = sc[4 * j][1], s2 = sc[4 * j][2], s3 = sc[4 * j][3];
        s0 = m1 ? sc[4 * j + 1][0] : s0; s1 = m1 ? sc[4 * j + 1][1] : s1; s2 = m1 ? sc[4 * j + 1][2] : s2; s3 = m1 ? sc[4 * j + 1][3] : s3;
        s0 = m2 ? sc[4 * j + 2][0] : s0; s1 = m2 ? sc[4 * j + 2][1] : s1; s2 = m2 ? sc[4 * j + 2][2] : s2; s3 = m2 ? sc[4 * j + 2][3] : s3;
        s0 = m3 ? sc[4 * j + 3][0] : s0; s1 = m3 ? sc[4 * j + 3][1] : s1; s2 = m3 ? sc[4 * j + 3][2] : s2; s3 = m3 ? sc[4 * j + 3][3] : s3;
        const float d0 = qpos - (float)(iv.x & 0xffffu), d1 = qpos - (float)(iv.x >> 16), d2 = qpos - (float)(iv.y & 0xffffu), d3 = qpos - (float)(iv.y >> 16);
        float y0 = s0 * qs - slope2 * d0, y1 = s1 * qs - slope2 * d1, y2 = s2 * qs - slope2 * d2, y3 = s3 * qs - slope2 * d3;
        y0 = 64 * j + 0 < nrel ? y0 : -INFINITY; y1 = 64 * j + 1 < nrel ? y1 : -INFINITY; y2 = 64 * j + 2 < nrel ? y2 : -INFINITY; y3 = 64 * j + 3 < nrel ? y3 : -INFINITY;
        yv[j][0] = y0; yv[j][1] = y1; yv[j][2] = y2; yv[j][3] = y3; mx = fmaxf(fmaxf(fmaxf(y0, y1), fmaxf(y2, y3)), mx); } }
    mx = fmaxf(mx, dpp_f(mx, 0x128)); mx = fmaxf(mx, dpp_f(mx, 0x124));
    mx = fmaxf(mx, __shfl_xor(mx, 16)); mx = fmaxf(mx, __shfl_xor(mx, 32));
    float l = 0.f; unsigned pd[4];
#pragma unroll
    for (int j = 0; j < 4; ++j) {
        const float p0 = __builtin_amdgcn_exp2f(yv[j][0] - mx), p1 = __builtin_amdgcn_exp2f(yv[j][1] - mx), p2 = __builtin_amdgcn_exp2f(yv[j][2] - mx), p3 = __builtin_amdgcn_exp2f(yv[j][3] - mx);
        l += (p0 + p1) + (p2 + p3);
        pd[j] = pack4_fp8(p0 * 256.f, p1 * 256.f, p2 * 256.f, p3 * 256.f); }
    l += dpp_f(l, 0x128); l += dpp_f(l, 0x124);
    l += __shfl_xor(l, 16); l += __shfl_xor(l, 32);
    long pf[8];
#pragma unroll
    for (int j = 0; j < 4; ++j) {
        const unsigned t1 = (unsigned)__builtin_amdgcn_update_dpp(0, (int)pd[j], 0x104, 0xf, 0xf, true), t2 = (unsigned)__builtin_amdgcn_update_dpp(0, (int)pd[j], 0x108, 0xf, 0xf, true),
                       t3 = (unsigned)__builtin_amdgcn_update_dpp(0, (int)pd[j], 0x10C, 0xf, 0xf, true);
        pf[2 * j] = (long)(((unsigned long long)t1 << 32) | pd[j]); pf[2 * j + 1] = (long)(((unsigned long long)t3 << 32) | t2); }
    f32x4 oa[8];
#pragma unroll
    for (int m = 0; m < 8; ++m) oa[m] = (f32x4){0.f, 0.f, 0.f, 0.f};
    const int trow = 8 * g + ((lane & 15) >> 1);
    const unsigned tr0 = (unsigned)(uintptr_t)vb + trow * 128 + 16 * ((trow >> 1) & 7) + 8 * (lane & 1);
    unsigned trm[8];
#pragma unroll
    for (int m = 0; m < 8; ++m) trm[m] = tr0 ^ (16u * m);
    unsigned vw[4];
#pragma unroll
    for (int c4 = 0; c4 < 4; ++c4) { const int rho = 8 * c4 + vrl; vw[c4] = (unsigned)(uintptr_t)vb + rho * 128 + 16 * (vch ^ ((rho >> 1) & 7)); }
    unsigned vm = 0;
#pragma unroll
    for (int kk = 0; kk < 8; ++kk) vm |= (__ballot((lane & 15) < 4 && pf[kk] != 0) != 0ull) ? (1u << kk) : 0u;
#pragma unroll
    for (int s = 0; s < 8; ++s) { const int kk = 7 - s; const bool on = (vm >> kk) & 1u;
        if (on) {
#pragma unroll
            for (int c4 = 0; c4 < 4; ++c4) *(LAS u32x4*)(uintptr_t)(vw[c4] + (s & 1) * 4096) = vd[s % 3][c4]; }
        if (s + 3 < 8 && ((vm >> (kk - 3)) & 1u)) AT_VLOAD(vd[s % 3], kk - 3);
        if (on) {
#pragma unroll
            for (int m = 0; m < 8; ++m) {
                typedef int v2i32 __attribute__((ext_vector_type(2)));
                const v2i32 t = __builtin_amdgcn_ds_read_tr8_b64_v2i32((LAS v2i32*)(uintptr_t)(trm[m] + (s & 1) * 4096));
                oa[m] = __builtin_amdgcn_mfma_f32_16x16x32_fp8_fp8((long)(((unsigned long long)(unsigned)t[1] << 32) | (unsigned)t[0]), pf[kk], oa[m], 0, 0, 0); } }
    }
#undef AT_VLOAD
    const float inv = (1.f / 256.f) * fast_rcp(l);
    if (r < 4) { bf16_t* op = A.OA + row * 1024 + (size_t)(4 * kvh + r) * 128 + 4 * g;
#pragma unroll
        for (int m = 0; m < 8; ++m) { u32x2 o; o.x = cvt_pk_bf16(oa[m][0] * inv, oa[m][1] * inv); o.y = cvt_pk_bf16(oa[m][2] * inv, oa[m][3] * inv); *(u32x2*)(op + 16 * m) = o; } }
    LDS_WAIT();
}
__device__ __forceinline__ void at_phase(const Frame& F, const AtArgs& A) {
    const int xg = F.vcu >> 5, b = xg >> 1, j = 32 * (xg & 1) + (F.vcu & 31);
    LAS unsigned char* vb = F.lds + AT_VB + F.wave * 16384; LAS unsigned char* idxl = F.lds + AT_IDX + F.wave * 512;
#ifndef AT_REP
#define AT_REP 1
#endif
#define AT_T(qq) (64 * (64 * ((qq) >> 4) + j) + 8 * F.wave + (((qq) >> 1) & 7))
    for (int rep = AT_REP; rep > 0; --rep) {
        AtArgs A2 = A; if (rep > 1) A2.OA = A.DUMMY;
        AtPre Pa, Pb; at_preload(Pa, A2, b, 0, AT_T(0), F.lane);
        for (int qq = 0; qq < 32; qq += 2) {
            at_query(A2, Pa, Pb, true, AT_T(qq + 1), 1, vb, idxl, b, 0, AT_T(qq), F.lane);
            at_query(A2, Pb, Pa, qq + 2 < 32, AT_T((qq + 2) & 31), 0, vb, idxl, b, 1, AT_T(qq + 1), F.lane); } }
#undef AT_T
}

struct Args { const float* in[11]; float* out; unsigned char* ws; int ph_lo, ph_hi, li, pad; };
__global__ void __launch_bounds__(NWAVES * 64, 2) hyb_fwd(Args args) {
    extern __shared__ __attribute__((aligned(16))) unsigned char lds_raw[];
    Frame F;
    F.lds = (LAS unsigned char*)lds_raw;
    volatile LAS unsigned* MISC = (volatile LAS unsigned*)(F.lds + MISC_OFF);
    F.tid = threadIdx.x; F.lane = F.tid & 63; F.wave = __builtin_amdgcn_readfirstlane(F.tid >> 6);
    F.G = gridDim.x; { const int bx = blockIdx.x; F.vcu = (F.G % 8 == 0) ? (bx % 8) * (F.G / 8) + bx / 8 : bx; }
    unsigned char* ws = args.ws;
    gu32* ctl = (gu32*)(ws + WS_CTL);
    for (int u = F.tid; u < (LDS_BYTES - LDSCTL_OFF) / 4; u += NWAVES * 64) ((LAS unsigned*)(F.lds + LDSCTL_OFF))[u] = 0u;
    __syncthreads();
    const int lo = args.ph_lo, hi = args.ph_hi; const bool multi = (hi - lo) > 1;
    XcdBarrier bar; bar.bar = (unsigned*)(ctl + CW_BAR); bar.x = 0; bar.st = nullptr;
    if (multi) bar = xcd_barrier_post((unsigned*)(ctl + CW_BAR), MISC + 8);
#ifndef PHMASK
#define PHMASK 0x7f
#endif
#define IN(k) (((PHMASK >> (k)) & 1) && lo <= (k) && (k) < hi)
#define GRID_BAR(k) do { if (IN(k) && IN((k) + 1)) xcd_barrier(bar); } while (0)
    const float *x = args.in[0], *meta = args.in[1], *norm_g = args.in[2], *w_in = args.in[3], *lb_logits = args.in[4], *r_norm_g = args.in[5], *q_norm_g = args.in[6], *k_norm_g = args.in[7],
                *w_r = args.in[8], *w_a = args.in[9], *w_out = args.in[10];
    unsigned char *W1A8 = ws + WS_W1A8, *W1B8 = ws + WS_W1B8, *WR8 = ws + WS_WR8, *WA8 = ws + WS_WA8, *WO8 = ws + WS_WO8, *XN8 = ws + WS_XN8, *GR8 = ws + WS_GR8, *GA8 = ws + WS_GA8; bf16_t* W1AI = (bf16_t*)(ws + WS_W1AI);
    bf16_t *XN = (bf16_t*)(ws + WS_XN), *RQ = (bf16_t*)(ws + WS_RQ), *RF = (bf16_t*)(ws + WS_RF), *RV = (bf16_t*)(ws + WS_RV), *AQ = (bf16_t*)(ws + WS_AQ);
    bf16_t *AK = (bf16_t*)(ws + WS_AK), *AV = (bf16_t*)(ws + WS_AV), *IQ = (bf16_t*)(ws + WS_IQ), *IKC = (bf16_t*)(ws + WS_IKC); unsigned char *KN = ws + WS_KN, *VV = ws + WS_VV;
    float *IW = (float*)(ws + WS_IW), *LB = (float*)(ws + WS_LB), *SLOC = (float*)(ws + WS_SLOC), *DSEG = (float*)(ws + WS_DSEG);
    unsigned short* IDX = (unsigned short*)(ws + WS_IDX); int* CNT = (int*)(ws + WS_CNT);

#ifndef DUP
#define DUP -1
#endif
#define PH0() do { const P0Args a{x, meta, norm_g, w_in, lb_logits, w_r, w_a, w_out, W1A8, W1B8, WR8, WA8, WO8, XN8, W1AI, XN, LB}; p0_prologue(F, a); } while (0)
#define PH1() do { { pg8::TileOrder S; S.init(MROWS, N1A8, F.G, (int)blockIdx.x, 1, (const bf16_t*)XN8, (const bf16_t*)W1A8, (const bf16_t*)XN8, (const bf16_t*)W1A8); \
          const pg8::EpiP1 E{RQ, RF, RV, AQ, AK, AV, IQ, IKC, IW, 0, ZSCALE}; \
          pg8::gemm_phase<pg8::EpiP1, pg8::TileOrder, true, true, true>(F.lds, 512, S, E); } \
        { pg8::TileOrder S; S.init(MROWS, N1AI, F.G, (int)blockIdx.x, 1, XN, W1AI, XN, W1AI);     \
          const pg8::EpiP1 E{RQ, RF, RV, AQ, AK, AV, IQ, IKC, IW, 18, 1.f}; \
          pg8::gemm_phase<pg8::EpiP1, pg8::TileOrder, true, true, false>(F.lds, 1024, S, E); } } while (0)
#ifndef P2MASK
#define P2MASK 7
#endif
#define PH2() do { \
        if (P2MASK & 1) { const HgArgs a{RQ, RF, RV, RQ, LB, r_norm_g, SLOC, DSEG}; for (int rep = H1_REP; rep > 0; --rep) h1_unit(F, a); } \
        if (P2MASK & 2) { const KnArgs a{AK, AV, k_norm_g, KN, VV}; for (int rep = KN_REP; rep > 0; --rep) knorm_share(F, a); } \
        if (P2MASK & 4) { const IxArgs a{IQ, IKC, IW, IDX, CNT}; \
          for (int ub4 = 0; ub4 < 4 * IX_REP; ++ub4) { const int ub = (ub4 + 2 * (F.wave >> 2) + (F.wave & 1)) & 3;     \
            const int v = F.vcu, qg = ub == 0 ? v : ub == 1 ? 255 - v : ub == 2 ? ((v + 128) & 255) : 255 - ((v + 128) & 255); ix_unit(F, a, ub, qg); } } } while (0)
#ifndef P3MASK
#define P3MASK 3
#endif
#ifndef H3_REP
#define H3_REP 1
#endif
#ifndef H1_REP
#define H1_REP 1
#endif
#ifndef KN_REP
#define KN_REP 1
#endif
#ifndef IX_REP
#define IX_REP 1
#endif
#define PH3(ORP, OAP) do { \
        if (P3MASK & 1) { for (int rep = H3_REP; rep > 0; --rep) { const HgArgs a{RQ, RF, RV, rep > 1 ? (bf16_t*)args.out : ORP, LB, r_norm_g, SLOC, DSEG}; h3_unit(F, a); } } \
        __syncthreads(); \
        if (P3MASK & 2) { const AtArgs a{AQ, KN, VV, OAP, IDX, CNT, q_norm_g, (bf16_t*)args.out}; at_phase(F, a); } \
        __syncthreads(); } while (0)
#define PH4() do { pg8::TileOrder S; S.init(NTOK, N1B, F.G, (int)blockIdx.x, 1, (const bf16_t*)XN8, (const bf16_t*)W1B8, (const bf16_t*)XN8, (const bf16_t*)W1B8); \
        const pg8::EpiP4 E{ws}; \
        pg8::gemm_phase<pg8::EpiP4, pg8::TileOrder, true, true, true>(F.lds, 512, S, E); } while (0)
#define PH5() do { pg8::TileOrder S; S.init(NTOK, 1024, F.G, (int)blockIdx.x, 2, (const bf16_t*)GR8, (const bf16_t*)WR8, (const bf16_t*)GA8, (const bf16_t*)WA8); \
        const pg8::EpiP5 E{RF, RV, XN8}; \
        pg8::gemm_phase<pg8::EpiP5, pg8::TileOrder, true, true, true>(F.lds, 512, S, E); } while (0)
#define PH6() do { pg8::TileOrder S; S.init(NTOK, 1024, F.G, (int)blockIdx.x, 1, (const bf16_t*)XN8, (const bf16_t*)WO8, (const bf16_t*)XN8, (const bf16_t*)WO8); \
        const pg8::EpiP6 E{x, args.out}; \
        pg8::gemm_phase<pg8::EpiP6, pg8::TileOrder, true, true, true>(F.lds, 512, S, E); } while (0)

    if (IN(0)) { PH0(); }
    GRID_BAR(0);
    if (IN(1)) { PH1(); }
    GRID_BAR(1);
    if (IN(2)) { PH2(); }
    GRID_BAR(2);
    if (IN(3)) { PH3(RQ, AQ); }
    GRID_BAR(3);
    if (IN(4)) { PH4(); }
    GRID_BAR(4);
    if (IN(5)) { PH5(); }
    GRID_BAR(5);
    if (IN(6)) { PH6(); }
#undef IN
#undef GRID_BAR
}

extern "C" void kernel_launch(void* const* d_in, const int* in_sizes, int n_in, void* d_out, int out_size, void* d_ws, size_t ws_size, hipStream_t stream) {
    static int grid = 0;
    if (grid == 0) {
        if (n_in != 11 || in_sizes[0] != NTOK * DM || out_size != NTOK * DM || ws_size < WS_END) { fprintf(stderr, "kernel_launch: unexpected shapes (n_in %d, in0 %d, out %d, ws %zu); nothing launched\n", n_in, n_in > 0 ? in_sizes[0] : -1, out_size, ws_size); grid = -1; return; }
        int dev = 0, cus = 0, per_cu = 0;
        if (hipGetDevice(&dev) != hipSuccess || hipDeviceGetAttribute(&cus, hipDeviceAttributeMultiprocessorCount, dev) != hipSuccess) { grid = -1; return; }
        if (hipFuncSetAttribute((const void*)hyb_fwd, hipFuncAttributeMaxDynamicSharedMemorySize, LDS_BYTES) != hipSuccess) { fprintf(stderr, "kernel_launch: hipFuncSetAttribute failed\n"); grid = -1; return; }
        if (hipOccupancyMaxActiveBlocksPerMultiprocessor(&per_cu, (const void*)hyb_fwd, NWAVES * 64, LDS_BYTES) != hipSuccess || per_cu < 1) fprintf(stderr, "kernel_launch: occupancy query reports %d\n", per_cu);
        (void)hipGetLastError();
        grid = cus;
        if (grid != 256) fprintf(stderr, "kernel_launch: %d CUs; this kernel's unit maps assume 256\n", grid);
    }
    if (grid < 0) return;
    if (hipMemsetAsync((char*)d_ws + WS_CTL, 0, CTL_ZERO_BYTES, stream) != hipSuccess) return;
    Args a{};
    for (int i = 0; i < 11; ++i) a.in[i] = (const float*)d_in[i];
    a.out = (float*)d_out; a.ws = (unsigned char*)d_ws;
    a.ph_lo = 0; a.ph_hi = 7; a.li = 0;
    hipLaunchKernelGGL(hyb_fwd, dim3(grid), dim3(NWAVES * 64), LDS_BYTES, stream, a);
}
```

```cpp
#include <hip/hip_runtime.h>
#include <cstdio>
#include <cstdint>

#define GAS __attribute__((address_space(1)))
#define LAS __attribute__((address_space(3)))
#define PG8_LAS __attribute__((address_space(3)))
typedef unsigned short bf16_t;
typedef short bf16x8 __attribute__((ext_vector_type(8)));
typedef short s16x4 __attribute__((ext_vector_type(4)));
typedef float f32x4 __attribute__((ext_vector_type(4)));
typedef float f32x2 __attribute__((ext_vector_type(2)));
typedef unsigned u32x4 __attribute__((ext_vector_type(4)));
typedef unsigned u32x2 __attribute__((ext_vector_type(2)));
typedef GAS unsigned gu32;
typedef GAS unsigned long long gu64;
#define RLX_AGENT __ATOMIC_RELAXED, __HIP_MEMORY_SCOPE_AGENT

constexpr int NB = 4, SEQ = 8192, DM = 1024, NTOK = NB * SEQ;
constexpr int MROWS = NTOK + 256;
constexpr int META_ROW0 = NTOK + 48;
constexpr int NKEY = SEQ + 16;
constexpr int IKC_SUBS = (NKEY + 31) / 32;
constexpr int N1A = 5376, N1B = 4096;
constexpr float EPS = 1e-6f;
constexpr float LOG2E = 1.4426950408889634f;
constexpr int C_RQ = 0, C_RF = 1024, C_RI = 2048, C_RG = 3072, C_AQ = 4096, C_AK = 5120, C_AV = 5376, C_AG = 5632, C_IQ = 6656, C_IK = 7168, C_IW = 7232, C_MR = 7240, C_MA = 8264, D_IN = 9288;

constexpr size_t MiB = 1u << 20;
constexpr size_t WS_CTL = 0, CTL_ZERO_BYTES = 1 * MiB;
constexpr size_t WS_W1A8 = 1 * MiB, WS_W1AI = 6 * MiB, WS_W1B8 = 8 * MiB, WS_WR8 = 12 * MiB, WS_WA8 = 13 * MiB, WS_WO8 = 14 * MiB, WS_LB = 26 * MiB;
constexpr size_t WS_IW = 27 * MiB, WS_IKC = 29 * MiB, WS_XN = 34 * MiB, WS_RQ = 99 * MiB, WS_RF = 164 * MiB, WS_RV = 229 * MiB, WS_AQ = 294 * MiB;
constexpr size_t WS_AK = 359 * MiB, WS_AV = 376 * MiB, WS_IQ = 393 * MiB, WS_KN = 426 * MiB, WS_VV = 435 * MiB, WS_SLOC = 444 * MiB, WS_DSEG = 460 * MiB;
constexpr size_t WS_IDX = 461 * MiB, WS_CNT = 477 * MiB, WS_XN8 = 478 * MiB, WS_END = 511 * MiB;
constexpr size_t WS_GR8 = WS_XN, WS_GA8 = WS_XN + 32 * MiB;
constexpr int N1A8 = 4608, N1AI = 768;
constexpr float WSCALE = 32.f, ZSCALE = 1.f / 32.f;
static_assert((size_t)MROWS * 1024 * 2 <= 65 * MiB && (size_t)MROWS * 512 * 2 <= 33 * MiB && (size_t)MROWS * 256 * 2 <= 17 * MiB, "ws map");
static_assert((size_t)NB * 2 * NKEY * 128 <= 9 * MiB && (size_t)NB * IKC_SUBS * 4096 <= 5 * MiB && (size_t)MROWS * 8 * 4 <= 2 * MiB && (size_t)MROWS * 1024 <= 33 * MiB, "ws map");
constexpr int CW_TMO = 0, CW_CODE = 1, CW_BAR = 4096;

__device__ __forceinline__ float bf2f(unsigned v) { return __uint_as_float(v << 16); }
__device__ __forceinline__ float bflo(unsigned v) { return __uint_as_float(v << 16); }
__device__ __forceinline__ float bfhi(unsigned v) { return __uint_as_float(v & 0xffff0000u); }
__device__ __forceinline__ unsigned cvt_pk_bf16(float lo, float hi) { unsigned r; asm volatile("v_cvt_pk_bf16_f32 %0, %1, %2" : "=v"(r) : "v"(lo), "v"(hi)); return r; }
__device__ __forceinline__ unsigned pack4_fp8(float a, float b, float c, float d) { int r = __builtin_amdgcn_cvt_pk_fp8_f32(a, b, 0, false); r = __builtin_amdgcn_cvt_pk_fp8_f32(c, d, r, true); return (unsigned)r; }
__device__ __forceinline__ float fast_exp(float x) { return __builtin_amdgcn_exp2f(x * LOG2E); }
__device__ __forceinline__ float fast_rcp(float x) { return __builtin_amdgcn_rcpf(x); }
__device__ __forceinline__ float sigmoid_f(float v) { return fast_rcp(1.f + fast_exp(-v)); }
__device__ __forceinline__ float silu_f(float v) { return v * sigmoid_f(v); }
__device__ __forceinline__ float wave_sum(float v) {
#pragma unroll
    for (int o = 1; o < 64; o <<= 1) v += __shfl_xor(v, o);
    return v;
}

namespace pg8 {
constexpr int BM = 256, BK = 64, HALF = 128, HTB = HALF * BK * 2, STAGE_BYTES = 8 * HTB, NXCD = 8, WGM = 8;
__host__ __device__ __forceinline__ int lds_byte(int r, int c) { const int st = (r >> 4) * 2 + (c >> 5), rr = r & 15, cc = c & 31, ob = rr * 64 + cc * 2; return st * 1024 + (ob ^ (((ob >> 9) & 1) << 5)); }
__host__ __device__ __forceinline__ void stage_rc(int b, int& R, int& C) { const int st = b / 1024, sb = b % 1024, swz = sb ^ (((sb >> 9) & 1) << 5); R = (st >> 1) * 16 + swz / 64; C = (st & 1) * 32 + (swz % 64) / 2; }
__host__ __device__ __forceinline__ int perm32(int rho) { const int n = rho >> 4, i = rho & 15; return 8 * (i >> 2) + 4 * n + (i & 3); }

typedef int v8i32 __attribute__((ext_vector_type(8)));
__device__ __forceinline__ v8i32 pg8_cat(bf16x8 lo, bf16x8 hi) { const u32x4 a = __builtin_bit_cast(u32x4, lo), b = __builtin_bit_cast(u32x4, hi); return (v8i32){(int)a.x, (int)a.y, (int)a.z, (int)a.w, (int)b.x, (int)b.y, (int)b.z, (int)b.w}; }
__device__ __forceinline__ void pg8_mfma8(f32x4& acc, v8i32 a, v8i32 b, int scale) {
    asm volatile("v_mfma_scale_f32_16x16x128_f8f6f4 %0, %1, %2, %0, %3, %3 op_sel_hi:[0,0,0]" : "+v"(acc) : "v"(a), "v"(b), "v"(scale)); }
struct Unit { int pm, pn; const bf16_t* A; const bf16_t* Bt; int aux; };

struct TileOrder {
    int nM, nN, nwg, G, c, rep; const bf16_t* A[2]; const bf16_t* Bt[2];
    __device__ __forceinline__ void init(int M, int N, int G_, int c_, int rep_, const bf16_t* A0, const bf16_t* B0, const bf16_t* A1, const bf16_t* B1) {
        nM = M / BM; nN = N / BM; nwg = nM * nN; G = G_; c = c_; rep = rep_; A[0] = A0; A[1] = A1; Bt[0] = B0; Bt[1] = B1; }
    __device__ __forceinline__ bool next(int ii, Unit& u) const {
        const int i = (rep == 2) ? (ii >> 1) : ii, a = (rep == 2) ? (ii & 1) : 0;
        const long L = (long)i * G + c; if (L >= nwg) return false;
        int wgid = (int)L; { const int q = nwg / NXCD, r = nwg % NXCD, xcd = wgid % NXCD, off = wgid / NXCD; wgid = (xcd < r ? xcd * (q + 1) : r * (q + 1) + (xcd - r) * q) + off; }
        const int nig = WGM * nN, gid = wgid / nig, fm = gid * WGM, gsz = (nM - fm) < WGM ? (nM - fm) : WGM;
        u.pm = fm + ((wgid % nig) % gsz); u.pn = (wgid % nig) / gsz; u.aux = a; u.A = a ? A[1] : A[0]; u.Bt = a ? Bt[1] : Bt[0]; return true;
    }
    __device__ __forceinline__ void a_ready(const Unit&) const {}
    __device__ __forceinline__ void done(const Unit&) const {}
};


struct EpiP1 {
    static constexpr bool PERM = true, AFTER_DRAIN = false;
    __device__ __forceinline__ bool keep(const Unit&) const { return false; }
    bf16_t *RQ, *RF, *RV, *AQ, *AK, *AV, *IQ, *IKC; float* IW; int pn_off; float zs;
    __device__ __forceinline__ void operator()(const f32x4 (&acc)[2][2][4][2], const Unit& u, int wr, int wc, int fr, int fq) const {
        const int pn = u.pn + pn_off, row0 = u.pm * BM + wr * 64 + fr;
        if (pn < 20) {
            bf16_t* base; int ld, colt; bool act = false;
            if (pn < 4) { base = RQ; ld = 1024; colt = pn * 256; act = true; }
            else if (pn < 8) { base = RF; ld = 1024; colt = (pn - 4) * 256; }
            else if (pn < 12) { base = RV; ld = 1024; colt = (pn - 8) * 256; }
            else if (pn < 16) { base = AQ; ld = 1024; colt = (pn - 12) * 256; }
            else if (pn == 16) { base = AK; ld = 256; colt = 0; }
            else if (pn == 17) { base = AV; ld = 256; colt = 0; }
            else { base = IQ; ld = 512; colt = (pn - 18) * 256; }
            const int col0 = colt + wc * 32 + 8 * fq;
#pragma unroll
            for (int ai = 0; ai < 2; ++ai)
#pragma unroll
                for (int m = 0; m < 4; ++m) { bf16_t* rowp = base + (size_t)(row0 + ai * HALF + m * 16) * ld + col0;
#pragma unroll
                    for (int bj = 0; bj < 2; ++bj) { f32x4 v0 = acc[ai][bj][m][0] * zs, v1 = acc[ai][bj][m][1] * zs;
                        if (act) {
#pragma unroll
                            for (int e = 0; e < 4; ++e) { v0[e] = silu_f(v0[e]) * 0.08838834764831845f; v1[e] = silu_f(v1[e]) * 0.08838834764831845f; } }
                        u32x4 w; w.x = cvt_pk_bf16(v0[0], v0[1]); w.y = cvt_pk_bf16(v0[2], v0[3]); w.z = cvt_pk_bf16(v1[0], v1[1]); w.w = cvt_pk_bf16(v1[2], v1[3]);
                        *(u32x4*)(rowp + bj * HALF) = w; } }
        } else {
            const int c8 = wc * 32 + 8 * fq;
#pragma unroll
            for (int ai = 0; ai < 2; ++ai)
#pragma unroll
                for (int m = 0; m < 4; ++m) { const int r = row0 + ai * HALF + m * 16; const f32x4 v0 = acc[ai][0][m][0] * zs, v1 = acc[ai][0][m][1] * zs;
                    if (c8 < 64) {
                        u32x4 w; w.x = cvt_pk_bf16(v0[0], v0[1]); w.y = cvt_pk_bf16(v0[2], v0[3]); w.z = cvt_pk_bf16(v1[0], v1[1]); w.w = cvt_pk_bf16(v1[2], v1[3]);
                        if (r < NTOK) { const int b = r >> 13, j = 16 + (r & (SEQ - 1)); *(u32x4*)(IKC + ((size_t)b * IKC_SUBS + (j >> 5)) * 2048 + ((c8 >> 3) * 32 + (j & 31)) * 8) = w; }
                        else if (r >= META_ROW0 && r < META_ROW0 + 16) { const int j = r - META_ROW0;
#pragma unroll
                            for (int b = 0; b < NB; ++b) *(u32x4*)(IKC + ((size_t)b * IKC_SUBS + (j >> 5)) * 2048 + ((c8 >> 3) * 32 + (j & 31)) * 8) = w; }
                    } else if (c8 == 64) {
                        if (r < NTOK) { const float sc = 0.044194173824159216f;
                            *(f32x4*)(IW + (size_t)r * 8) = v0 * sc; *(f32x4*)(IW + (size_t)r * 8 + 4) = v1 * sc; }
                    } }
        }
    }
};
struct EpiP4 {
    static constexpr bool PERM = true, AFTER_DRAIN = false;
    __device__ __forceinline__ bool keep(const Unit&) const { return false; }
    unsigned char* ws;
    __device__ __forceinline__ void operator()(const f32x4 (&acc)[2][2][4][2], const Unit& u, int wr, int wc, int fr, int fq) const {
        const int pn = u.pn, row0 = u.pm * BM + wr * 64 + fr; const bool gate = pn < 8;
        const size_t boff = pn < 4 ? WS_RQ : pn < 8 ? WS_AQ : pn < 12 ? WS_RF : WS_RV;
        bf16_t* base = (bf16_t*)(ws + boff); unsigned char* g8 = ws + (pn < 4 ? WS_GR8 : WS_GA8);
        const int col0 = (pn & 3) * 256 + wc * 32 + 8 * fq;
        constexpr int PD = 7; u32x4 oq[PD + 1][2];
        if (gate) {
#pragma unroll
            for (int it = 0; it < PD; ++it)
#pragma unroll
                for (int bj = 0; bj < 2; ++bj) oq[it][bj] = *(const u32x4*)(base + (size_t)(row0 + (it >> 2) * HALF + (it & 3) * 16) * 1024 + col0 + bj * HALF); }
#pragma unroll
        for (int ai = 0; ai < 2; ++ai)
#pragma unroll
            for (int m = 0; m < 4; ++m) { const int it = ai * 4 + m; const size_t ro = (size_t)(row0 + ai * HALF + m * 16) * 1024 + col0; bf16_t* rowp = base + ro;
                if (gate && it + PD < 8) { const int ai2 = (it + PD) >> 2, m2 = (it + PD) & 3;
#pragma unroll
                    for (int bj = 0; bj < 2; ++bj) oq[(it + PD) % (PD + 1)][bj] = *(const u32x4*)(base + (size_t)(row0 + ai2 * HALF + m2 * 16) * 1024 + col0 + bj * HALF); }
#pragma unroll
                for (int bj = 0; bj < 2; ++bj) { f32x4 v0 = acc[ai][bj][m][0] * ZSCALE, v1 = acc[ai][bj][m][1] * ZSCALE;
                    if (gate) { const u32x4 o = oq[it % (PD + 1)][bj];
                        v0[0] = silu_f(v0[0]) * bflo(o.x); v0[1] = silu_f(v0[1]) * bfhi(o.x); v0[2] = silu_f(v0[2]) * bflo(o.y); v0[3] = silu_f(v0[3]) * bfhi(o.y);
                        v1[0] = silu_f(v1[0]) * bflo(o.z); v1[1] = silu_f(v1[1]) * bfhi(o.z); v1[2] = silu_f(v1[2]) * bflo(o.w); v1[3] = silu_f(v1[3]) * bfhi(o.w);
                        u32x2 w8; w8.x = pack4_fp8(v0[0], v0[1], v0[2], v0[3]); w8.y = pack4_fp8(v1[0], v1[1], v1[2], v1[3]);
                        *(u32x2*)(g8 + ro + bj * HALF) = w8;
                    } else {
#pragma unroll
                        for (int e = 0; e < 4; ++e) { v0[e] = sigmoid_f(v0[e]); v1[e] = sigmoid_f(v1[e]); }
                        u32x4 w; w.x = cvt_pk_bf16(v0[0], v0[1]); w.y = cvt_pk_bf16(v0[2], v0[3]); w.z = cvt_pk_bf16(v1[0], v1[1]); w.w = cvt_pk_bf16(v1[2], v1[3]);
                        *(u32x4*)(rowp + bj * HALF) = w; } }
                asm volatile("" ::: "memory"); }
    }
};
struct EpiP5 {
    static constexpr bool PERM = true, AFTER_DRAIN = false;
    __device__ __forceinline__ bool keep(const Unit& u) const { return u.aux == 0; }
    const bf16_t *SMR, *SMA; unsigned char* MG;
    __device__ __forceinline__ void operator()(f32x4 (&acc)[2][2][4][2], const Unit& u, int wr, int wc, int fr, int fq) const {
        const int row0 = u.pm * BM + wr * 64 + fr, col0 = u.pn * BM + wc * 32 + 8 * fq; const bool second = u.aux != 0;
        if (!second) {
#pragma unroll
            for (int ai = 0; ai < 2; ++ai) { u32x4 sa[4][2], sr[4][2];
#pragma unroll
                for (int m = 0; m < 4; ++m)
#pragma unroll
                    for (int bj = 0; bj < 2; ++bj) { const size_t o2 = (size_t)(row0 + ai * HALF + m * 16) * 1024 + col0 + bj * HALF;
                        sa[m][bj] = *(const u32x4*)(SMA + o2); sr[m][bj] = *(const u32x4*)(SMR + o2); }
#pragma unroll
                for (int m = 0; m < 4; ++m)
#pragma unroll
                    for (int bj = 0; bj < 2; ++bj) { const u32x4 a = sa[m][bj], s = sr[m][bj]; f32x4 v0 = acc[ai][bj][m][0], v1 = acc[ai][bj][m][1];
                        v0[0] *= bflo(s.x) * fast_rcp(fmaxf(bflo(a.x), 1e-30f)); v0[1] *= bfhi(s.x) * fast_rcp(fmaxf(bfhi(a.x), 1e-30f));
                        v0[2] *= bflo(s.y) * fast_rcp(fmaxf(bflo(a.y), 1e-30f)); v0[3] *= bfhi(s.y) * fast_rcp(fmaxf(bfhi(a.y), 1e-30f));
                        v1[0] *= bflo(s.z) * fast_rcp(fmaxf(bflo(a.z), 1e-30f)); v1[1] *= bfhi(s.z) * fast_rcp(fmaxf(bfhi(a.z), 1e-30f));
                        v1[2] *= bflo(s.w) * fast_rcp(fmaxf(bflo(a.w), 1e-30f)); v1[3] *= bfhi(s.w) * fast_rcp(fmaxf(bfhi(a.w), 1e-30f));
                        acc[ai][bj][m][0] = v0; acc[ai][bj][m][1] = v1; } }
        } else { u32x4 sa[2][4][2];
#pragma unroll
            for (int ai = 0; ai < 2; ++ai)
#pragma unroll
                for (int m = 0; m < 4; ++m)
#pragma unroll
                    for (int bj = 0; bj < 2; ++bj) sa[ai][m][bj] = *(const u32x4*)(SMA + (size_t)(row0 + ai * HALF + m * 16) * 1024 + col0 + bj * HALF);
#pragma unroll
            for (int ai = 0; ai < 2; ++ai)
#pragma unroll
                for (int m = 0; m < 4; ++m)
#pragma unroll
                    for (int bj = 0; bj < 2; ++bj) { const u32x4 a = sa[ai][m][bj]; const f32x4 v0 = acc[ai][bj][m][0], v1 = acc[ai][bj][m][1]; u32x2 w;
                        w.x = pack4_fp8(v0[0] * fmaxf(bflo(a.x), 1e-30f) * ZSCALE, v0[1] * fmaxf(bfhi(a.x), 1e-30f) * ZSCALE, v0[2] * fmaxf(bflo(a.y), 1e-30f) * ZSCALE, v0[3] * fmaxf(bfhi(a.y), 1e-30f) * ZSCALE);
                        w.y = pack4_fp8(v1[0] * fmaxf(bflo(a.z), 1e-30f) * ZSCALE, v1[1] * fmaxf(bfhi(a.z), 1e-30f) * ZSCALE, v1[2] * fmaxf(bflo(a.w), 1e-30f) * ZSCALE, v1[3] * fmaxf(bfhi(a.w), 1e-30f) * ZSCALE);
                        *(u32x2*)(MG + (size_t)(row0 + ai * HALF + m * 16) * 1024 + col0 + bj * HALF) = w; }
        }
    }
};
struct EpiP6 {
    static constexpr bool PERM = true, AFTER_DRAIN = false;
    __device__ __forceinline__ bool keep(const Unit&) const { return false; }
    const float* X; float* OUT;
    __device__ __forceinline__ void operator()(const f32x4 (&acc)[2][2][4][2], const Unit& u, int wr, int wc, int fr, int fq) const {
        const int row0 = u.pm * BM + wr * 64 + fr, col0 = u.pn * BM + wc * 32 + 8 * fq;
#pragma unroll
        for (int ai = 0; ai < 2; ++ai) { f32x4 xv[4][2][2];
#pragma unroll
            for (int m = 0; m < 4; ++m)
#pragma unroll
                for (int bj = 0; bj < 2; ++bj)
#pragma unroll
                    for (int n = 0; n < 2; ++n) xv[m][bj][n] = *(const f32x4*)(X + (size_t)(row0 + ai * HALF + m * 16) * 1024 + col0 + bj * HALF + n * 4);
#pragma unroll
            for (int m = 0; m < 4; ++m)
#pragma unroll
                for (int bj = 0; bj < 2; ++bj)
#pragma unroll
                    for (int n = 0; n < 2; ++n) *(f32x4*)(OUT + (size_t)(row0 + ai * HALF + m * 16) * 1024 + col0 + bj * HALF + n * 4) = xv[m][bj][n] + acc[ai][bj][m][n] * ZSCALE; }
    }
};

template <class Epi, class Sched, bool ALIGN_EPI = false, bool SP2 = false, bool FP8 = false>
__device__ __forceinline__ void gemm_phase(PG8_LAS unsigned char* lds, const int K, const Sched& S, const Epi& E) {
    const int tid = threadIdx.x, wid = __builtin_amdgcn_readfirstlane(tid >> 6), lane = tid & 63, wr = wid >> 2, wc = wid & 3, fr = lane & 15, fq = lane >> 4;
    const int nt = K / BK;
    unsigned voffA[2], voffB[2];
#pragma unroll
    for (int i = 0; i < 2; ++i) { int R, C; stage_rc(tid * 16 + i * 8192, R, C); const int Rb = Epi::PERM ? ((R & ~31) + perm32(R & 31)) : R;
        voffA[i] = (unsigned)(R * K + C) * 2u; voffB[i] = (unsigned)(Rb * K + C) * 2u; }
    const size_t kstep = (size_t)(BK * 2);
    const size_t hstep = (size_t)HALF * K * 2;
    const size_t tstep = 2 * hstep;
    const unsigned ldsw = (unsigned)wid * 1024u;
    const int aoff = lds_byte(wr * 64 + fr, fq * 8), boff = lds_byte(wc * 32 + fr, fq * 8);
#define PG8_SA(b, h) (((b) * 2 + (h)) * HTB)
#define PG8_SB(b, h) ((4 + (b) * 2 + (h)) * HTB)
#define PG8_STAGE(bufoff, gbase, voff) do { _Pragma("unroll") for (int _i = 0; _i < 2; ++_i) \
        __builtin_amdgcn_global_load_lds((const unsigned*)((const char*)(gbase) + (voff)[_i]), (PG8_LAS unsigned*)(lds + (bufoff) + ldsw + _i * 8192), 16, 0, 0); } while (0)
#define PG8_LDA(dst, b, h) do { _Pragma("unroll") for (int m = 0; m < 4; ++m) _Pragma("unroll") for (int k = 0; k < 2; ++k) dst[m][k] = *(const PG8_LAS bf16x8*)(lds + PG8_SA(b, h) + aoff + m * 2048 + k * 1024); } while (0)
#define PG8_LDB(dst, b, h) do { _Pragma("unroll") for (int n = 0; n < 2; ++n) _Pragma("unroll") for (int k = 0; k < 2; ++k) dst[n][k] = *(const PG8_LAS bf16x8*)(lds + PG8_SB(b, h) + boff + n * 2048 + k * 1024); } while (0)
#define PG8_MMA(ai, bj, At, Bt) do { __builtin_amdgcn_s_setprio(1); _Pragma("unroll") for (int m = 0; m < 4; ++m) _Pragma("unroll") for (int n = 0; n < 2; ++n) { \
        if constexpr (FP8) { pg8_mfma8(acc[ai][bj][m][n], pg8_cat(Bt[n][0], Bt[n][1]), pg8_cat(At[m][0], At[m][1]), one8); } \
        else { _Pragma("unroll") for (int k = 0; k < 2; ++k) acc[ai][bj][m][n] = __builtin_amdgcn_mfma_f32_16x16x32_bf16(Bt[n][k], At[m][k], acc[ai][bj][m][n], 0, 0, 0); } } __builtin_amdgcn_s_setprio(0); } while (0)
#define PG8_WAIT_V(n) asm volatile("s_waitcnt vmcnt(" #n ")" ::: "memory")
#define PG8_WAIT_L(n) asm volatile("s_waitcnt lgkmcnt(" #n ")" ::: "memory")
#define PG8_BAR __builtin_amdgcn_s_barrier()
#define PG8_SCHED __builtin_amdgcn_sched_barrier(0)
    Unit cur, nxt; int ui = 0;
    if (!S.next(0, cur)) return;
    f32x4 acc[2][2][4][2];
    const int one8 = 0x7f7f7f7f;
#pragma unroll
    for (int a = 0; a < 2; ++a)
#pragma unroll
        for (int b = 0; b < 2; ++b)
#pragma unroll
            for (int m = 0; m < 4; ++m)
#pragma unroll
                for (int n = 0; n < 2; ++n) acc[a][b][m][n] = (f32x4){0.f, 0.f, 0.f, 0.f};
    bf16x8 At[4][2], B0[2][2], B1[2][2];
    const char* cA = (const char*)cur.A + (size_t)cur.pm * tstep; const char* cB = (const char*)cur.Bt + (size_t)cur.pn * tstep;
    S.a_ready(cur);
    if constexpr (SP2) {
        PG8_STAGE(PG8_SB(0, 0), cB, voffB); PG8_STAGE(PG8_SB(0, 1), cB + hstep, voffB); PG8_STAGE(PG8_SA(0, 0), cA, voffA); PG8_STAGE(PG8_SA(0, 1), cA + hstep, voffA);
        if (wr == 1) PG8_BAR;
        PG8_WAIT_V(2); PG8_BAR;
        PG8_STAGE(PG8_SB(1, 0), cB + kstep, voffB); PG8_STAGE(PG8_SA(1, 0), cA + kstep, voffA); PG8_STAGE(PG8_SB(1, 1), cB + hstep + kstep, voffB);
        PG8_WAIT_V(6); PG8_BAR;
    } else {
        PG8_STAGE(PG8_SB(0, 0), cB, voffB); PG8_STAGE(PG8_SA(0, 0), cA, voffA); PG8_STAGE(PG8_SB(0, 1), cB + hstep, voffB); PG8_STAGE(PG8_SA(0, 1), cA + hstep, voffA);
        if (wr == 1) PG8_BAR;
        PG8_WAIT_V(4); PG8_BAR;
        PG8_STAGE(PG8_SB(1, 0), cB + kstep, voffB); PG8_STAGE(PG8_SA(1, 0), cA + kstep, voffA); PG8_STAGE(PG8_SB(1, 1), cB + hstep + kstep, voffB);
        PG8_WAIT_V(6); PG8_BAR;
    }
    for (;;) {
        const bool has_next = S.next(ui + 1, nxt);
        const char* nA = has_next ? (const char*)nxt.A + (size_t)nxt.pm * tstep : cA; const char* nB = has_next ? (const char*)nxt.Bt + (size_t)nxt.pn * tstep : cB;
#pragma unroll 1
        for (int t = 0; t < nt; t += 2) {
            const bool last = (t == nt - 2);
            const char* a1 = cA + (size_t)(t + 1) * kstep;
            const char* a2 = last ? nA : cA + (size_t)(t + 2) * kstep; const char* b2 = last ? nB : cB + (size_t)(t + 2) * kstep;
            const char* a3 = a2 + kstep; const char* b3 = b2 + kstep;
            if (last && has_next) S.a_ready(nxt);
            if constexpr (SP2) {
            PG8_LDB(B0, 0, 0); PG8_LDB(B1, 0, 1); PG8_SCHED; PG8_LDA(At, 0, 0); PG8_STAGE(PG8_SA(1, 1), a1 + hstep, voffA);
            PG8_WAIT_V(8); PG8_WAIT_L(0); PG8_BAR; PG8_MMA(0, 0, At, B0); PG8_MMA(0, 1, At, B1); PG8_BAR; PG8_SCHED;
            PG8_LDA(At, 0, 1); PG8_STAGE(PG8_SB(0, 0), b2, voffB); PG8_STAGE(PG8_SB(0, 1), b2 + hstep, voffB); PG8_STAGE(PG8_SA(0, 0), a2, voffA);
            PG8_WAIT_V(8); PG8_WAIT_L(0); PG8_BAR; PG8_MMA(1, 0, At, B0); PG8_MMA(1, 1, At, B1); PG8_BAR; PG8_SCHED;
            PG8_LDB(B0, 1, 0); PG8_LDB(B1, 1, 1); PG8_SCHED; PG8_LDA(At, 1, 0); PG8_STAGE(PG8_SA(0, 1), a2 + hstep, voffA);
            PG8_WAIT_V(8); PG8_WAIT_L(0); PG8_BAR; PG8_MMA(0, 0, At, B0); PG8_MMA(0, 1, At, B1); PG8_BAR; PG8_SCHED;
            PG8_LDA(At, 1, 1); PG8_STAGE(PG8_SB(1, 0), b3, voffB); PG8_STAGE(PG8_SB(1, 1), b3 + hstep, voffB); PG8_STAGE(PG8_SA(1, 0), a3, voffA);
            PG8_WAIT_V(8); PG8_WAIT_L(0); PG8_BAR; PG8_MMA(1, 0, At, B0); PG8_MMA(1, 1, At, B1); PG8_BAR; PG8_SCHED;
            } else {
            PG8_LDB(B0, 0, 0); PG8_SCHED; PG8_LDA(At, 0, 0); PG8_STAGE(PG8_SA(1, 1), a1 + hstep, voffA);
            PG8_WAIT_L(8); PG8_BAR; PG8_WAIT_L(0); PG8_MMA(0, 0, At, B0); PG8_BAR; PG8_SCHED;
            PG8_LDB(B1, 0, 1); PG8_STAGE(PG8_SB(0, 0), b2, voffB);
            PG8_BAR; PG8_WAIT_L(0); PG8_MMA(0, 1, At, B1); PG8_BAR;
            PG8_LDA(At, 0, 1); PG8_STAGE(PG8_SA(0, 0), a2, voffA);
            PG8_BAR; PG8_WAIT_L(0); PG8_MMA(1, 0, At, B0); PG8_BAR; PG8_SCHED;
            PG8_STAGE(PG8_SB(0, 1), b2 + hstep, voffB);
            PG8_WAIT_V(6); PG8_BAR; PG8_MMA(1, 1, At, B1); PG8_BAR;
            PG8_LDB(B0, 1, 0); PG8_SCHED; PG8_LDA(At, 1, 0); PG8_STAGE(PG8_SA(0, 1), a2 + hstep, voffA);
            PG8_WAIT_L(8); PG8_BAR; PG8_WAIT_L(0); PG8_MMA(0, 0, At, B0); PG8_BAR; PG8_SCHED;
            PG8_LDB(B1, 1, 1); PG8_STAGE(PG8_SB(1, 0), b3, voffB);
            PG8_BAR; PG8_WAIT_L(0); PG8_MMA(0, 1, At, B1); PG8_BAR;
            PG8_LDA(At, 1, 1); PG8_STAGE(PG8_SA(1, 0), a3, voffA);
            PG8_BAR; PG8_WAIT_L(0); PG8_MMA(1, 0, At, B0); PG8_BAR; PG8_SCHED;
            PG8_STAGE(PG8_SB(1, 1), b3 + hstep, voffB);
            PG8_WAIT_V(6); PG8_BAR; PG8_MMA(1, 1, At, B1); PG8_BAR;
            }
        }
        if constexpr (ALIGN_EPI) { if (wr == 0) PG8_BAR; }
        if constexpr (FP8) {
#pragma unroll
            for (int a_ = 0; a_ < 2; ++a_) asm volatile("s_nop 15\n\ts_nop 15" : "+v"(acc[a_][0][0][0]), "+v"(acc[a_][0][0][1]), "+v"(acc[a_][0][1][0]), "+v"(acc[a_][0][1][1]), "+v"(acc[a_][0][2][0]), "+v"(acc[a_][0][2][1]), "+v"(acc[a_][0][3][0]), "+v"(acc[a_][0][3][1]),
                                                                        "+v"(acc[a_][1][0][0]), "+v"(acc[a_][1][0][1]), "+v"(acc[a_][1][1][0]), "+v"(acc[a_][1][1][1]), "+v"(acc[a_][1][2][0]), "+v"(acc[a_][1][2][1]), "+v"(acc[a_][1][3][0]), "+v"(acc[a_][1][3][1]));
        }
        if constexpr (!Epi::AFTER_DRAIN) { E(acc, cur, wr, wc, fr, fq); S.done(cur); }
        if (!has_next) break;
        if (!E.keep(cur)) {
#pragma unroll
        for (int a = 0; a < 2; ++a)
#pragma unroll
            for (int b = 0; b < 2; ++b)
#pragma unroll
                for (int m = 0; m < 4; ++m)
#pragma unroll
                    for (int n = 0; n < 2; ++n) acc[a][b][m][n] = (f32x4){0.f, 0.f, 0.f, 0.f};
        }
        cur = nxt; cA = nA; cB = nB; ++ui;
        if constexpr (ALIGN_EPI) { if (wr == 1) PG8_BAR; }
    }
    PG8_WAIT_V(0);
    if constexpr (!ALIGN_EPI) { if (wr == 0) PG8_BAR; }
    PG8_BAR;
    if constexpr (Epi::AFTER_DRAIN) { E.fused(acc, cur, wr, wc, fr, fq, lds, wid, lane); S.done(cur); }
#undef PG8_SA
#undef PG8_SB
#undef PG8_STAGE
#undef PG8_LDA
#undef PG8_LDB
#undef PG8_MMA
#undef PG8_WAIT_V
#undef PG8_WAIT_L
#undef PG8_BAR
#undef PG8_SCHED
}
}

constexpr int RING_BYTES = 131072;
constexpr int LDSCTL_OFF = 143360, MISC_OFF = LDSCTL_OFF + 320;
constexpr int LDS_BYTES = 147456;
constexpr int NWAVES = 8;

#define LDS_WAIT() asm volatile("s_waitcnt lgkmcnt(0)" ::: "memory")
#define VM_WAIT() asm volatile("s_waitcnt vmcnt(0)" ::: "memory")

#define XB_TMO      128
#define XB_XCNT(j)  (256  + 64 * (j))
#define XB_XSUB(j)  (1280 + 64 * (j))
#define XB_XGEN(j)  (2304 + 64 * (j))
#define XB_TOP      3328
#define XB_TOPGEN   3392
#define XCD_BAR_WORDS 3456
#define XB_SPIN_CAP (1u << 18)

__device__ __forceinline__ unsigned xb_ld(unsigned* p)              { return __hip_atomic_load(p, __ATOMIC_RELAXED, __HIP_MEMORY_SCOPE_AGENT); }
__device__ __forceinline__ unsigned xb_add(unsigned* p, unsigned v) { return __hip_atomic_fetch_add(p, v, __ATOMIC_RELAXED, __HIP_MEMORY_SCOPE_AGENT); }
__device__ __forceinline__ unsigned xb_xcc_id() { return (unsigned)__builtin_amdgcn_s_getreg((3 << 11) | 20) & 0xFu; }
#define XB_SPIN(cond, bar) do { unsigned _sp = 0; while (cond) { __builtin_amdgcn_s_sleep(1); \
    if ((++_sp & 255u) == 0u) { if (xb_ld(&(bar)[XB_TMO])) break; if (_sp > XB_SPIN_CAP) { atomicAdd(&(bar)[XB_TMO], 1u); break; } } } } while (0)

struct XcdBarrier {
    unsigned* bar; unsigned x;
    volatile LAS unsigned* st;
};

__device__ __forceinline__ XcdBarrier xcd_barrier_post(unsigned* bar, volatile LAS unsigned* st) {
    XcdBarrier b; b.bar = bar; b.x = xb_xcc_id(); b.st = st;
    if (threadIdx.x == 0) (void)xb_add(&bar[XB_XCNT(b.x)], 1u);
    return b;
}
__device__ __forceinline__ void xcd_barrier_complete(unsigned* bar, unsigned x, unsigned& nloc, unsigned& nx) {
    const unsigned G = gridDim.x * gridDim.y * gridDim.z;
    unsigned sum, cnt, mine, sp = 0u;
    for (;;) {
        sum = 0u; cnt = 0u; mine = 0u;
#pragma unroll
        for (unsigned j = 0; j < 16; ++j) { const unsigned c = xb_ld(&bar[XB_XCNT(j)]); sum += c; cnt += (c > 0u) ? 1u : 0u; mine = (j == x) ? c : mine; }
        if (sum == G) break;
        __builtin_amdgcn_s_sleep(1);
        if ((++sp & 255u) == 0u) { if (xb_ld(&bar[XB_TMO])) break; if (sp > XB_SPIN_CAP) { atomicAdd(&bar[XB_TMO], 1u); break; } }
    }
    nloc = mine > 0u ? mine : 1u; nx = cnt > 0u ? cnt : 1u;
}

__device__ __forceinline__ void xcd_barrier(const XcdBarrier& b) {
    asm volatile("s_waitcnt vmcnt(0)" ::: "memory");
    __syncthreads();
    if (threadIdx.x == 0) {
        unsigned* bar = b.bar;
        __builtin_amdgcn_s_waitcnt(0);
        unsigned nloc = b.st[0], nx = b.st[1];
        if (nloc == 0u) { xcd_barrier_complete(bar, b.x, nloc, nx); b.st[0] = nloc; b.st[1] = nx; }
        const unsigned old = xb_add(&bar[XB_XSUB(b.x)], 1u);
        const unsigned gen = old / nloc;
        if (old + 1u == (gen + 1u) * nloc) {
            __builtin_amdgcn_fence(__ATOMIC_RELEASE, "agent");
            asm volatile("s_waitcnt vmcnt(0)" ::: "memory");
            const unsigned og = xb_add(&bar[XB_TOP], 1u);
            const unsigned tg = og / nx;
            if (og + 1u == (tg + 1u) * nx) xb_add(&bar[XB_TOPGEN], 1u);
            else XB_SPIN(xb_ld(&bar[XB_TOPGEN]) == tg, bar);
            __builtin_amdgcn_fence(__ATOMIC_ACQUIRE, "agent");
            xb_add(&bar[XB_XGEN(b.x)], 1u);
            asm volatile("s_waitcnt vmcnt(0)" ::: "memory");
        } else {
            XB_SPIN(xb_ld(&bar[XB_XGEN(b.x)]) == gen, bar);
            __builtin_amdgcn_fence(__ATOMIC_ACQUIRE, "agent");
            asm volatile("s_waitcnt vmcnt(0)" ::: "memory");
        }
    }
    __syncthreads();
}


struct Frame {
    LAS unsigned char* lds;
    int tid, lane, wave, vcu, G;
};

__device__ __forceinline__ int src_col_1a(int n) {
    if (n < 3072) return n;
    if (n < 4096) return C_AQ + (n - 3072);
    if (n < 4608) return C_AK + (n - 4096);
    if (n < 5120) return C_IQ + (n - 4608);
    if (n < 5192) return C_IK + (n - 5120);
    return -1;
}
__device__ __forceinline__ int src_col_1b(int n) {
    if (n < 1024) return C_RG + n;
    if (n < 2048) return C_AG + (n - 1024);
    return C_MR + (n - 2048);
}
template <bool FP8>
__device__ __forceinline__ void p0_transpose_item(const float* W, int ldw, int mode, int n_base, void* WT, int nblk, LAS float* scr, int item, int lane) {
    const int kb = item / nblk, nb = item % nblk, k0 = 64 * kb, n0 = 32 * nb;
    const int n = n_base + n0 + (lane & 31); const int sc = mode == 0 ? n : mode == 1 ? src_col_1a(n) : src_col_1b(n);
    { float wv_[32];
#pragma unroll
      for (int i = 0; i < 32; ++i) { const int kk = 2 * i + (lane >> 5); wv_[i] = sc >= 0 ? W[(size_t)(k0 + kk) * ldw + sc] : 0.f; }
#pragma unroll
      for (int i = 0; i < 32; ++i) { const int kk = 2 * i + (lane >> 5); scr[kk * 33 + (lane & 31)] = wv_[i]; } }
    LDS_WAIT(); asm volatile("" ::: "memory");
    const int c = lane & 7;
#pragma unroll
    for (int j = 0; j < 4; ++j) { const int nn = (lane >> 3) + 8 * j; const LAS float* s = scr + (8 * c) * 33 + nn;
        if (FP8) { u32x2 o; o.x = pack4_fp8(s[0 * 33] * WSCALE, s[1 * 33] * WSCALE, s[2 * 33] * WSCALE, s[3 * 33] * WSCALE); o.y = pack4_fp8(s[4 * 33] * WSCALE, s[5 * 33] * WSCALE, s[6 * 33] * WSCALE, s[7 * 33] * WSCALE);
            *(u32x2*)((unsigned char*)WT + (size_t)(n0 + nn) * 1024 + k0 + 8 * c) = o; }
        else { u32x4 o; o.x = cvt_pk_bf16(s[0 * 33], s[1 * 33]); o.y = cvt_pk_bf16(s[2 * 33], s[3 * 33]); o.z = cvt_pk_bf16(s[4 * 33], s[5 * 33]); o.w = cvt_pk_bf16(s[6 * 33], s[7 * 33]);
            *(u32x4*)((bf16_t*)WT + (size_t)(n0 + nn) * 1024 + k0 + 8 * c) = o; } }
    LDS_WAIT(); asm volatile("" ::: "memory");
}
__device__ __forceinline__ void rms_row_to_bf16(const float* xrow, const float* g, bf16_t* orow, unsigned char* orow8, int lane) {
    const f32x4* xr = (const f32x4*)xrow + lane; const f32x4* gr = (const f32x4*)g + lane;
    f32x4 v[4]; float s = 0.f;
#pragma unroll
    for (int j = 0; j < 4; ++j) { v[j] = xr[64 * j]; s += (v[j].x * v[j].x + v[j].y * v[j].y) + (v[j].z * v[j].z + v[j].w * v[j].w); }
    const float rstd = __builtin_amdgcn_rsqf(wave_sum(s) * (1.f / 1024.f) + EPS);
    u32x2* o8 = (u32x2*)orow + lane; unsigned* o4 = (unsigned*)orow8 + lane;
#pragma unroll
    for (int j = 0; j < 4; ++j) { const f32x4 gg = gr[64 * j]; const float a = v[j].x * rstd * gg.x, b = v[j].y * rstd * gg.y, c = v[j].z * rstd * gg.z, d = v[j].w * rstd * gg.w;
        u32x2 w; w.x = cvt_pk_bf16(a, b); w.y = cvt_pk_bf16(c, d); o8[64 * j] = w; o4[64 * j] = pack4_fp8(a, b, c, d); }
}
struct P0Args { const float *x, *meta, *norm_g, *w_in, *lb_logits, *w_r, *w_a, *w_out; unsigned char *W1A8, *W1B8, *WR8, *WA8, *WO8, *XN8; bf16_t *W1AI, *XN; float* LB; };
__device__ __forceinline__ void p0_prologue(const Frame& F, const P0Args& a) {
    LAS float* scr = (LAS float*)(F.lds + F.wave * 16384);
    const int gw = F.vcu * NWAVES + F.wave, NGW = F.G * NWAVES;
    constexpr int I_A = 16 * (N1A8 / 32), I_I = 16 * (N1AI / 32), I_B = 16 * (N1B / 32), I_S = 16 * 32;
    constexpr int NITEMS = I_A + I_I + I_B + 3 * I_S;
    for (int it = gw; it < NITEMS; it += NGW) {
        int r = it;
        if (r < I_A) { p0_transpose_item<true>(a.w_in, D_IN, 1, 0, a.W1A8, N1A8 / 32, scr, r, F.lane); continue; } r -= I_A;
        if (r < I_I) { p0_transpose_item<false>(a.w_in, D_IN, 1, N1A8, a.W1AI, N1AI / 32, scr, r, F.lane); continue; } r -= I_I;
        if (r < I_B) { p0_transpose_item<true>(a.w_in, D_IN, 2, 0, a.W1B8, N1B / 32, scr, r, F.lane); continue; } r -= I_B;
        if (r < I_S) { p0_transpose_item<true>(a.w_r, 1024, 0, 0, a.WR8, 32, scr, r, F.lane); continue; } r -= I_S;
        if (r < I_S) { p0_transpose_item<true>(a.w_a, 1024, 0, 0, a.WA8, 32, scr, r, F.lane); continue; } r -= I_S;
        p0_transpose_item<true>(a.w_out, 1024, 0, 0, a.WO8, 32, scr, r, F.lane);
    }
    { constexpr int RPP = 8; f32x4 gg[4];
#pragma unroll
      for (int j = 0; j < 4; ++j) gg[j] = ((const f32x4*)a.norm_g)[F.lane + 64 * j];
      for (int m0 = gw; m0 < NTOK; m0 += RPP * NGW) {
        f32x4 v[RPP][4]; float s[RPP];
#pragma unroll
        for (int q = 0; q < RPP; ++q) { const int m = m0 + q * NGW; const f32x4* xr = (const f32x4*)(a.x + (size_t)(m < NTOK ? m : m0) * DM) + F.lane;
#pragma unroll
            for (int j = 0; j < 4; ++j) v[q][j] = xr[64 * j]; }
#pragma unroll
        for (int q = 0; q < RPP; ++q) { float t = 0.f;
#pragma unroll
            for (int j = 0; j < 4; ++j) t += (v[q][j].x * v[q][j].x + v[q][j].y * v[q][j].y) + (v[q][j].z * v[q][j].z + v[q][j].w * v[q][j].w);
            s[q] = t; }
#pragma unroll
        for (int o = 1; o < 64; o <<= 1) {
#pragma unroll
            for (int q = 0; q < RPP; ++q) s[q] += __shfl_xor(s[q], o); }
#pragma unroll
        for (int q = 0; q < RPP; ++q) { const int m = m0 + q * NGW; if (m >= NTOK) continue;
            const float rstd = __builtin_amdgcn_rsqf(s[q] * (1.f / 1024.f) + EPS);
            u32x2* o8 = (u32x2*)(a.XN + (size_t)m * DM) + F.lane; unsigned* o4 = (unsigned*)(a.XN8 + (size_t)m * DM) + F.lane;
#pragma unroll
            for (int j = 0; j < 4; ++j) { const float c0 = v[q][j].x * rstd * gg[j].x, c1 = v[q][j].y * rstd * gg[j].y, c2 = v[q][j].z * rstd * gg[j].z, c3 = v[q][j].w * rstd * gg[j].w;
                u32x2 w; w.x = cvt_pk_bf16(c0, c1); w.y = cvt_pk_bf16(c2, c3); o8[64 * j] = w; o4[64 * j] = pack4_fp8(c0, c1, c2, c3); } } } }
    for (int m = NTOK + gw; m < MROWS; m += NGW) {
        if (m < NTOK) rms_row_to_bf16(a.x + (size_t)m * DM, a.norm_g, a.XN + (size_t)m * DM, a.XN8 + (size_t)m * DM, F.lane);
        else if (m >= META_ROW0 && m < META_ROW0 + 16) rms_row_to_bf16(a.meta + (size_t)(m - META_ROW0) * DM, a.norm_g, a.XN + (size_t)m * DM, a.XN8 + (size_t)m * DM, F.lane);
        else { u32x2* o8 = (u32x2*)(a.XN + (size_t)m * DM) + F.lane; unsigned* o4 = (unsigned*)(a.XN8 + (size_t)m * DM) + F.lane; const u32x2 z = {0u, 0u};
#pragma unroll
            for (int j = 0; j < 4; ++j) { o8[64 * j] = z; o4[64 * j] = 0u; } }
    }
    if (blockIdx.x == 0) {
        for (int k = F.tid; k < 1024; k += NWAVES * 64) { const float l0 = a.lb_logits[k], l1 = a.lb_logits[1024 + k]; a.LB[k] = 1.f / (1.f + __expf(l1 - l0)); }
    }
}

constexpr int HG_QT = 0, HG_KT = 17408, HG_KHT = 34816, HG_VT = 53248, HG_PL = 71680, HG_SW = 80896, HG_OT = 115712, HG_PART = 133120, HG_DV = 137216, HG_P2 = 137728, HG_END = 139776;
static_assert(HG_END <= LDSCTL_OFF, "HGRN LDS map");
struct HgArgs { const bf16_t *RQ, *RF, *RV; bf16_t* OR_; const float *LB, *RNG; float *SLOC, *DSEG; };

template <int CTRL> __device__ __forceinline__ float dpp_f_(float v) { return __builtin_bit_cast(float, __builtin_amdgcn_update_dpp(0, __builtin_bit_cast(int, v), CTRL, 0xf, 0xf, true)); }
#define dpp_f(v, ctrl) dpp_f_<ctrl>(v)
__device__ __forceinline__ f32x4 mfma16(bf16x8 a, bf16x8 b, f32x4 c) { return __builtin_amdgcn_mfma_f32_16x16x32_bf16(a, b, c, 0, 0, 0); }
__device__ __forceinline__ bf16x8 lds_b128(LAS unsigned char* p) { return *(LAS bf16x8*)p; }

struct HgRegs { unsigned F2[8], V2[8], Q2[8]; };
template <bool FULL>
__device__ __forceinline__ void hg_load(HgRegs& R, const HgArgs& A, size_t row0, int h, int lane, int w) {
    const size_t cb = row0 * 1024 + (size_t)h * 128 + 2 * lane;
#pragma unroll
    for (int i = 0; i < 8; ++i) { const size_t o = cb + (size_t)(8 * w + i) * 1024; R.F2[i] = *(const unsigned*)(A.RF + o); R.V2[i] = *(const unsigned*)(A.RV + o); if (FULL) R.Q2[i] = *(const unsigned*)(A.RQ + o); }
}
template <bool FULL>
__device__ __forceinline__ void hg_chunk(LAS unsigned char* lds, const HgArgs& A, const HgRegs& R, size_t row0, int h, int validFrom, f32x4 (&Sacc)[8], float& logD0, float& logD1, int tid, int lane, int w, float lb0, float lb1, float gn) {
    const int r = lane & 15, g = lane >> 4;
    {
        const unsigned (&F2)[8] = R.F2; const unsigned (&V2)[8] = R.V2; const unsigned (&Q2)[8] = R.Q2;
        float c0[8], c1[8], k0[8], k1[8]; float run0 = 1.f, run1 = 1.f;
#pragma unroll
        for (int i = 0; i < 8; ++i) { const bool valid = (8 * w + i) >= validFrom;
            const float f0 = lb0 + (1.f - lb0) * sigmoid_f(bflo(F2[i])), f1 = lb1 + (1.f - lb1) * sigmoid_f(bfhi(F2[i]));
            k0[i] = valid ? 1.f - f0 : 0.f; k1[i] = valid ? 1.f - f1 : 0.f;
            run0 *= valid ? f0 : 1.f; run1 *= valid ? f1 : 1.f; c0[i] = run0; c1[i] = run1; }
        *(LAS f32x2*)(lds + HG_PART + (w * 128 + 2 * lane) * 4) = (f32x2){run0, run1};
        LDS_WAIT(); __syncthreads();
        float off0 = 1.f, off1 = 1.f, tot0 = 1.f, tot1 = 1.f;
#pragma unroll
        for (int ww = 0; ww < 8; ++ww) { const f32x2 p = *(LAS f32x2*)(lds + HG_PART + (ww * 128 + 2 * lane) * 4); if (ww < w) { off0 *= p.x; off1 *= p.y; } tot0 *= p.x; tot1 *= p.y; }
        logD0 *= tot0; logD1 *= tot1;
        const float ebl0 = tot0, ebl1 = tot1;
        float kh0[8], kh1[8];
#pragma unroll
        for (int i = 0; i < 8; ++i) { const float e0 = off0 * c0[i], e1 = off1 * c1[i];
            const float kt0 = k0[i] * fast_rcp(e0), kt1 = k1[i] * fast_rcp(e1);
            kh0[i] = kt0 * ebl0; kh1[i] = kt1 * ebl1;
            if (FULL) { const int t = 8 * w + i;
                *(LAS unsigned*)(lds + HG_QT + t * 272 + 4 * lane) = cvt_pk_bf16(bflo(Q2[i]) * e0, bfhi(Q2[i]) * e1);
                *(LAS unsigned*)(lds + HG_KT + t * 272 + 4 * lane) = cvt_pk_bf16(kt0, kt1); } }
        { u32x4 a, b; a.x = cvt_pk_bf16(kh0[0], kh0[1]); a.y = cvt_pk_bf16(kh0[2], kh0[3]); a.z = cvt_pk_bf16(kh0[4], kh0[5]); a.w = cvt_pk_bf16(kh0[6], kh0[7]);
          b.x = cvt_pk_bf16(kh1[0], kh1[1]); b.y = cvt_pk_bf16(kh1[2], kh1[3]); b.z = cvt_pk_bf16(kh1[4], kh1[5]); b.w = cvt_pk_bf16(kh1[6], kh1[7]);
          *(LAS u32x4*)(lds + HG_KHT + (2 * lane) * 144 + 16 * w) = a; *(LAS u32x4*)(lds + HG_KHT + (2 * lane + 1) * 144 + 16 * w) = b; }
        { u32x4 a, b;
          a.x = (V2[0] & 0xffffu) | (V2[1] << 16); a.y = (V2[2] & 0xffffu) | (V2[3] << 16); a.z = (V2[4] & 0xffffu) | (V2[5] << 16); a.w = (V2[6] & 0xffffu) | (V2[7] << 16);
          b.x = (V2[0] >> 16) | (V2[1] & 0xffff0000u); b.y = (V2[2] >> 16) | (V2[3] & 0xffff0000u); b.z = (V2[4] >> 16) | (V2[5] & 0xffff0000u); b.w = (V2[6] >> 16) | (V2[7] & 0xffff0000u);
          *(LAS u32x4*)(lds + HG_VT + (2 * lane) * 144 + 16 * w) = a; *(LAS u32x4*)(lds + HG_VT + (2 * lane + 1) * 144 + 16 * w) = b; }
        if (w == 0) *(LAS f32x2*)(lds + HG_DV + 8 * lane) = (f32x2){ebl0, ebl1};
    }
    f32x4 oacc[4];
    if (FULL) {
#pragma unroll
        for (int i = 0; i < 8; ++i) { u32x2 pk; pk.x = cvt_pk_bf16(Sacc[i][0], Sacc[i][1]); pk.y = cvt_pk_bf16(Sacc[i][2], Sacc[i][3]);
            *(LAS u32x2*)(lds + HG_SW + w * 4352 + r * 272 + (16 * i + 4 * g) * 2) = pk; }
    }
    LDS_WAIT(); __syncthreads();
    if (FULL) {
#pragma unroll
        for (int rep = 0; rep < 2; ++rep) {
            const int id = rep == 0 ? w : 8 + w;
            if (rep == 1 && w >= 2) break;
            int tt, st;
            if (id == 0) { tt = 0; st = 0; } else if (id < 3) { tt = 1; st = id - 1; } else if (id < 6) { tt = 2; st = id - 3; } else { tt = 3; st = id - 6; }
            f32x4 acc = {0.f, 0.f, 0.f, 0.f};
#pragma unroll
            for (int ks = 0; ks < 4; ++ks) { const bf16x8 a = lds_b128(lds + HG_KT + (16 * st + r) * 272 + (32 * ks + 8 * g) * 2), b = lds_b128(lds + HG_QT + (16 * tt + r) * 272 + (32 * ks + 8 * g) * 2); acc = mfma16(a, b, acc); }
            asm volatile("s_nop 15" : "+v"(acc));
            if (st == tt) {
#pragma unroll
                for (int e = 0; e < 4; ++e) if (4 * g + e > r) acc[e] = 0.f; }
            u32x2 pk; pk.x = cvt_pk_bf16(acc[0], acc[1]); pk.y = cvt_pk_bf16(acc[2], acc[3]);
            *(LAS u32x2*)(lds + HG_PL + (16 * tt + r) * 144 + (16 * st + 4 * g) * 2) = pk;
        }
        LDS_WAIT(); __syncthreads();
#pragma unroll
        for (int tt = 0; tt < 4; ++tt) { f32x4 o = {0.f, 0.f, 0.f, 0.f};
#pragma unroll
            for (int ks = 0; ks < 4; ++ks) { const bf16x8 a = lds_b128(lds + HG_QT + (16 * tt + r) * 272 + (32 * ks + 8 * g) * 2), b = lds_b128(lds + HG_SW + w * 4352 + r * 272 + (32 * ks + 8 * g) * 2); o = mfma16(a, b, o); }
#pragma unroll
            for (int ks = 0; ks < 2; ++ks) { if (ks == 1 && tt < 2) break;
                const bf16x8 a = lds_b128(lds + HG_PL + (16 * tt + r) * 144 + (32 * ks + 8 * g) * 2), b = lds_b128(lds + HG_VT + (16 * w + r) * 144 + (32 * ks + 8 * g) * 2); o = mfma16(a, b, o); }
            oacc[tt] = o; }
    }
#pragma unroll
    for (int i = 0; i < 8; ++i) { const f32x4 dd = *(LAS f32x4*)(lds + HG_DV + (16 * i + 4 * g) * 4); f32x4 s = Sacc[i] * dd;
#pragma unroll
        for (int ks = 0; ks < 2; ++ks) { const bf16x8 a = lds_b128(lds + HG_KHT + (16 * i + r) * 144 + (32 * ks + 8 * g) * 2), b = lds_b128(lds + HG_VT + (16 * w + r) * 144 + (32 * ks + 8 * g) * 2); s = mfma16(a, b, s); }
        Sacc[i] = s; }
    if (FULL) {
#pragma unroll
        for (int tt = 0; tt < 4; ++tt)
#pragma unroll
            for (int e = 0; e < 4; ++e) { float ss = oacc[tt][e] * oacc[tt][e];
                ss += dpp_f(ss, 0xB1); ss += dpp_f(ss, 0x4E); ss += dpp_f(ss, 0x141); ss += dpp_f(ss, 0x140);
                if (r == 0) *(LAS float*)(lds + HG_P2 + ((16 * tt + 4 * g + e) * 8 + w) * 4) = ss; }
        LDS_WAIT(); __syncthreads();
#pragma unroll
        for (int tt = 0; tt < 4; ++tt)
#pragma unroll
            for (int e = 0; e < 4; ++e) { const int t = 16 * tt + 4 * g + e;
                const f32x4 pa = *(LAS f32x4*)(lds + HG_P2 + t * 32), pb = *(LAS f32x4*)(lds + HG_P2 + t * 32 + 16); const float ss = ((pa[0] + pa[1]) + (pa[2] + pa[3])) + ((pb[0] + pb[1]) + (pb[2] + pb[3]));
                const float v = oacc[tt][e] * (__builtin_amdgcn_rsqf(ss * (1.f / 128.f) + EPS)) * gn;
                *(LAS unsigned short*)(lds + HG_OT + t * 272 + (16 * w + r) * 2) = (unsigned short)(cvt_pk_bf16(v, 0.f) & 0xffffu); }
        LDS_WAIT(); __syncthreads();
        { const int t = tid >> 3;
#pragma unroll
          for (int j = 0; j < 2; ++j) { const int ch = (tid & 7) * 2 + j; *(u32x4*)(A.OR_ + (row0 + t) * 1024 + (size_t)h * 128 + ch * 8) = *(LAS u32x4*)(lds + HG_OT + t * 272 + ch * 16); } }
    } else { LDS_WAIT(); __syncthreads(); }
}
__device__ __forceinline__ void hg_unit_ids(int u, int& b, int& h, int& seg) { b = u >> 6; h = (u >> 3) & 7; seg = u & 7; }
__device__ __forceinline__ void h1_unit(const Frame& F, const HgArgs& A) {
    int b, h, seg; hg_unit_ids(F.vcu, b, h, seg);
    f32x4 Sacc[8];
#pragma unroll
    for (int i = 0; i < 8; ++i) Sacc[i] = (f32x4){0.f, 0.f, 0.f, 0.f};
    float ld0 = 1.f, ld1 = 1.f;
    const size_t rbase = (size_t)b * SEQ + (size_t)(16 * seg) * 64;
    const float lb0 = A.LB[h * 128 + 2 * F.lane], lb1 = A.LB[h * 128 + 2 * F.lane + 1], gn = A.RNG[16 * F.wave + (F.lane & 15)];
    HgRegs Ra, Rb;
    if (seg == 0) { hg_load<false>(Ra, A, (size_t)NTOK, h, F.lane, F.wave); hg_load<false>(Rb, A, rbase, h, F.lane, F.wave); hg_chunk<false>(F.lds, A, Ra, (size_t)NTOK, h, 48, Sacc, ld0, ld1, F.tid, F.lane, F.wave, lb0, lb1, gn); }
    else hg_load<false>(Rb, A, rbase, h, F.lane, F.wave);
    for (int c = 0; c < 16; c += 2) {
        hg_load<false>(Ra, A, rbase + (size_t)(c + 1) * 64, h, F.lane, F.wave);
        hg_chunk<false>(F.lds, A, Rb, rbase + (size_t)c * 64, h, 0, Sacc, ld0, ld1, F.tid, F.lane, F.wave, lb0, lb1, gn);
        hg_load<false>(Rb, A, rbase + (size_t)(c + 2 < 16 ? c + 2 : 15) * 64, h, F.lane, F.wave);
        hg_chunk<false>(F.lds, A, Ra, rbase + (size_t)(c + 1) * 64, h, 0, Sacc, ld0, ld1, F.tid, F.lane, F.wave, lb0, lb1, gn);
    }
    float* sl = A.SLOC + (size_t)F.vcu * 16384 + F.wave * 2048 + F.lane;
#pragma unroll
    for (int i = 0; i < 8; ++i)
#pragma unroll
        for (int e = 0; e < 4; ++e) sl[(i * 4 + e) * 64] = Sacc[i][e];
    if (F.wave == 0) { A.DSEG[F.vcu * 128 + 2 * F.lane] = ld0; A.DSEG[F.vcu * 128 + 2 * F.lane + 1] = ld1; }
}
__device__ __forceinline__ void h3_unit(const Frame& F, const HgArgs& A) {
    int b, h, seg; hg_unit_ids(F.vcu, b, h, seg);
    const int g = F.lane >> 4;
    f32x4 Sacc[8];
#pragma unroll
    for (int i = 0; i < 8; ++i) Sacc[i] = (f32x4){0.f, 0.f, 0.f, 0.f};
    for (int j = 0; j < seg; j += 2) {
        const bool two = j + 1 < seg; const int ua = (F.vcu & ~7) + j, ub = two ? ua + 1 : ua;
        const float* sa = A.SLOC + (size_t)ua * 16384 + F.wave * 2048 + F.lane; const float* da = A.DSEG + ua * 128;
        const float* sb = A.SLOC + (size_t)ub * 16384 + F.wave * 2048 + F.lane; const float* db = A.DSEG + ub * 128;
        f32x4 dda[8], ddb[8]; float la[32], lb[32];
#pragma unroll
        for (int i = 0; i < 8; ++i) { dda[i] = *(const f32x4*)(da + 16 * i + 4 * g); ddb[i] = *(const f32x4*)(db + 16 * i + 4 * g);
#pragma unroll
            for (int e = 0; e < 4; ++e) { la[i * 4 + e] = sa[(i * 4 + e) * 64]; lb[i * 4 + e] = sb[(i * 4 + e) * 64]; } }
#pragma unroll
        for (int i = 0; i < 8; ++i)
#pragma unroll
            for (int e = 0; e < 4; ++e) { const float s1 = Sacc[i][e] * dda[i][e] + la[i * 4 + e]; Sacc[i][e] = two ? s1 * ddb[i][e] + lb[i * 4 + e] : s1; } }
    for (int i = F.tid; i < 64 * 36; i += NWAVES * 64) *(LAS unsigned*)(F.lds + HG_PL + i * 4) = 0u;
    LDS_WAIT(); __syncthreads();
    float ld0 = 1.f, ld1 = 1.f;
    const size_t rbase = (size_t)b * SEQ + (size_t)(16 * seg) * 64;
    const float lb0 = A.LB[h * 128 + 2 * F.lane], lb1 = A.LB[h * 128 + 2 * F.lane + 1], gn = A.RNG[16 * F.wave + (F.lane & 15)];
    HgRegs Ra, Rb;
    if (seg == 0) { hg_load<false>(Ra, A, (size_t)NTOK, h, F.lane, F.wave); hg_load<true>(Rb, A, rbase, h, F.lane, F.wave); hg_chunk<false>(F.lds, A, Ra, (size_t)NTOK, h, 48, Sacc, ld0, ld1, F.tid, F.lane, F.wave, lb0, lb1, gn); }
    else hg_load<true>(Rb, A, rbase, h, F.lane, F.wave);
    for (int c = 0; c < 16; c += 2) {
        hg_load<true>(Ra, A, rbase + (size_t)(c + 1) * 64, h, F.lane, F.wave);
        hg_chunk<true>(F.lds, A, Rb, rbase + (size_t)c * 64, h, 0, Sacc, ld0, ld1, F.tid, F.lane, F.wave, lb0, lb1, gn);
        hg_load<true>(Rb, A, rbase + (size_t)(c + 2 < 16 ? c + 2 : 15) * 64, h, F.lane, F.wave);
        hg_chunk<true>(F.lds, A, Ra, rbase + (size_t)(c + 1) * 64, h, 0, Sacc, ld0, ld1, F.tid, F.lane, F.wave, lb0, lb1, gn);
    }
}

struct KnArgs { const bf16_t *AK, *AV; const float* GK; unsigned char *KN, *VV; };
__device__ __forceinline__ void knorm_share(const Frame& F, const KnArgs& A) {
    const int gw = F.vcu * NWAVES + F.wave, NGW = F.G * NWAVES, sub = F.lane >> 4, part = F.lane & 15;
    const f32x4 g0 = *(const f32x4*)(A.GK + 8 * part), g1 = *(const f32x4*)(A.GK + 8 * part + 4);
    constexpr int KB = 4;
    for (int vb0 = gw * 4; vb0 < NB * 2 * NKEY; vb0 += KB * NGW * 4) {
        u32x4 kk[KB], vv[KB];
#pragma unroll
        for (int q = 0; q < KB; ++q) { const int v0 = vb0 + q * NGW * 4; const int v = (v0 < NB * 2 * NKEY ? v0 : vb0) + sub;
            const int b = v / (2 * NKEY), rem = v % (2 * NKEY), kvh = rem / NKEY, j = rem % NKEY;
            const size_t srow = j < 16 ? (size_t)(META_ROW0 + j) : (size_t)b * SEQ + (j - 16);
            kk[q] = *(const u32x4*)(A.AK + srow * 256 + kvh * 128 + 8 * part); vv[q] = *(const u32x4*)(A.AV + srow * 256 + kvh * 128 + 8 * part); }
#pragma unroll
        for (int q = 0; q < KB; ++q) { const int v0 = vb0 + q * NGW * 4; if (v0 >= NB * 2 * NKEY) continue;
            const int v = v0 + sub;
            const float x0 = bflo(kk[q].x), x1 = bfhi(kk[q].x), x2 = bflo(kk[q].y), x3 = bfhi(kk[q].y), x4 = bflo(kk[q].z), x5 = bfhi(kk[q].z), x6 = bflo(kk[q].w), x7 = bfhi(kk[q].w);
            float ss = ((x0 * x0 + x1 * x1) + (x2 * x2 + x3 * x3)) + ((x4 * x4 + x5 * x5) + (x6 * x6 + x7 * x7));
            ss += __shfl_xor(ss, 1); ss += __shfl_xor(ss, 2); ss += __shfl_xor(ss, 4); ss += __shfl_xor(ss, 8);
            const float rstd = __builtin_amdgcn_rsqf(ss * (1.f / 128.f) + EPS);
            int k0 = __builtin_amdgcn_cvt_pk_fp8_f32(x0 * rstd * g0[0], x1 * rstd * g0[1], 0, false); k0 = __builtin_amdgcn_cvt_pk_fp8_f32(x2 * rstd * g0[2], x3 * rstd * g0[3], k0, true);
            int k1 = __builtin_amdgcn_cvt_pk_fp8_f32(x4 * rstd * g1[0], x5 * rstd * g1[1], 0, false); k1 = __builtin_amdgcn_cvt_pk_fp8_f32(x6 * rstd * g1[2], x7 * rstd * g1[3], k1, true);
            int w0 = __builtin_amdgcn_cvt_pk_fp8_f32(bflo(vv[q].x), bfhi(vv[q].x), 0, false); w0 = __builtin_amdgcn_cvt_pk_fp8_f32(bflo(vv[q].y), bfhi(vv[q].y), w0, true);
            int w1 = __builtin_amdgcn_cvt_pk_fp8_f32(bflo(vv[q].z), bfhi(vv[q].z), 0, false); w1 = __builtin_amdgcn_cvt_pk_fp8_f32(bflo(vv[q].w), bfhi(vv[q].w), w1, true);
            *(u32x2*)(A.KN + (size_t)v * 128 + 8 * part) = (u32x2){(unsigned)k0, (unsigned)k1};
            *(u32x2*)(A.VV + (size_t)v * 128 + 8 * part) = (u32x2){(unsigned)w0, (unsigned)w1}; }
    }
}

constexpr int IX_HIST = 0, IX_CAND = 8192, CB_CAP = 704, IX_QB = CB_CAP * 6, IX_END = IX_CAND + 8 * 4 * IX_QB;
struct IxArgs { const bf16_t *IQ, *IKC; const float* IW; unsigned short* IDX; int* CNT; };

__device__ __forceinline__ unsigned sortable_key(unsigned bits) { return bits ^ ((bits >> 31) ? 0xffffffffu : 0x80000000u); }
__device__ __forceinline__ float key_to_float(unsigned k) { return __uint_as_float((k & 0x80000000u) ? (k ^ 0x80000000u) : ~k); }
__device__ __forceinline__ float vmax0(float a) { float r; asm("v_max_f32_e32 %0, 0, %1" : "=v"(r) : "v"(a)); return r; }
__device__ __forceinline__ float vfma(float a, float b, float c) { float r; asm("v_fma_f32 %0, %1, %2, %3" : "=v"(r) : "v"(a), "v"(b), "v"(c)); return r; }

__device__ __forceinline__ void radix_scan(LAS unsigned* hist, int lane, unsigned need, unsigned& bin, unsigned& above, unsigned& cbin) {
    const u32x4 c = *(LAS u32x4*)(hist + 4 * lane);
    const unsigned tot = c.x + c.y + c.z + c.w; unsigned inc = tot;
    inc += (unsigned)__builtin_amdgcn_update_dpp(0, (int)inc, 0x111, 0xf, 0xf, false);
    inc += (unsigned)__builtin_amdgcn_update_dpp(0, (int)inc, 0x112, 0xf, 0xf, false);
    inc += (unsigned)__builtin_amdgcn_update_dpp(0, (int)inc, 0x114, 0xf, 0xf, false);
    inc += (unsigned)__builtin_amdgcn_update_dpp(0, (int)inc, 0x118, 0xf, 0xf, false);
    { const unsigned t0 = (unsigned)__builtin_amdgcn_readlane((int)inc, 15), t1 = (unsigned)__builtin_amdgcn_readlane((int)inc, 31), t2 = (unsigned)__builtin_amdgcn_readlane((int)inc, 47);
      const int row = lane >> 4; inc += (row >= 1 ? t0 : 0u) + (row >= 2 ? t1 : 0u) + (row >= 3 ? t2 : 0u); }
    const unsigned total = (unsigned)__builtin_amdgcn_readlane((int)inc, 63);
    const unsigned a3 = total - inc, a2 = a3 + c.w, a1 = a2 + c.z, a0 = a1 + c.y;
    int fb = -1; unsigned fa = 0, fc = 0;
    if (a3 < need && need <= a3 + c.w) { fb = 4 * lane + 3; fa = a3; fc = c.w; }
    else if (a2 < need && need <= a2 + c.z) { fb = 4 * lane + 2; fa = a2; fc = c.z; }
    else if (a1 < need && need <= a1 + c.y) { fb = 4 * lane + 1; fa = a1; fc = c.y; }
    else if (a0 < need && need <= a0 + c.x) { fb = 4 * lane; fa = a0; fc = c.x; }
    const unsigned long long bm = __ballot(fb >= 0);
    const int src = bm ? __builtin_ctzll(bm) : 0;
    bin = (unsigned)__builtin_amdgcn_readlane(fb, src); above = (unsigned)__builtin_amdgcn_readlane((int)fa, src); cbin = (unsigned)__builtin_amdgcn_readlane((int)fc, src);
}
template <int NE = CB_CAP / 64>
__device__ __forceinline__ float topk_select(LAS unsigned char* qb, int n, LAS unsigned* hist, int lane, unsigned short* idx_out, int& kept, unsigned need0 = 256u) {
    asm volatile("" ::: "memory");
    unsigned key[NE], ix[NE]; unsigned vmask = 0;
#pragma unroll
    for (int i = 0; i < NE; ++i) { const int e = lane + 64 * i; key[i] = 0; ix[i] = 0;
        if (e < n) { key[i] = sortable_key(*(LAS unsigned*)(qb + 4 * e)); ix[i] = *(LAS unsigned short*)(qb + 4 * CB_CAP + 2 * e); vmask |= 1u << i; } }
    unsigned kmask = 0, kval = 0, need = need0; int pass0 = 0;
    { const unsigned d0 = (unsigned)__builtin_amdgcn_readfirstlane((int)(key[0] >> 24)); bool diff = false;
#pragma unroll
      for (int i = 0; i < NE; ++i) diff |= ((vmask >> i) & 1u) && (key[i] >> 24) != d0;
      if (__ballot(diff) == 0ull) { kval = d0 << 24; kmask = 0xff000000u; pass0 = 1; } }
    const int npass = idx_out ? 3 : 2;
    unsigned above_tot = 0; bool whole = false;
#pragma unroll 1
    for (int pass = pass0; pass < npass; ++pass) { const int shift = 24 - 8 * pass;
        *(LAS u32x4*)(hist + 4 * lane) = (u32x4){0u, 0u, 0u, 0u};
        if (pass == 0) {
            const unsigned d0 = key[0] >> 24; unsigned c0 = 0;
#pragma unroll
            for (int i = 0; i < NE; ++i) if ((vmask >> i) & 1u) { const unsigned d = key[i] >> 24; if (d == d0) ++c0; else __hip_atomic_fetch_add(hist + d, 1u, __ATOMIC_RELAXED, __HIP_MEMORY_SCOPE_WORKGROUP); }
            if (vmask & 1u) __hip_atomic_fetch_add(hist + d0, c0, __ATOMIC_RELAXED, __HIP_MEMORY_SCOPE_WORKGROUP);
        } else {
#pragma unroll
            for (int i = 0; i < NE; ++i) if (((vmask >> i) & 1u) && (key[i] & kmask) == kval) __hip_atomic_fetch_add(hist + ((key[i] >> shift) & 255u), 1u, __ATOMIC_RELAXED, __HIP_MEMORY_SCOPE_WORKGROUP);
        }
        LDS_WAIT();
        unsigned bin, above, cbin; radix_scan(hist, lane, need, bin, above, cbin);
        kval |= bin << shift; kmask |= 255u << shift; need -= above; above_tot += above;
        if (cbin == need) { whole = true; break; }
        if (pass == npass - 1 && !idx_out) { if (above_tot + cbin <= CB_CAP - 192) { need = cbin; whole = true; } }
    }
    unsigned base = 0, bbin = 0;
    if (whole) {
#pragma unroll
        for (int i = 0; i < NE; ++i) { const bool sel = ((vmask >> i) & 1u) && (key[i] & kmask) >= kval;
            const unsigned long long bm = __ballot(sel);
            const unsigned pos = base + __builtin_amdgcn_mbcnt_hi((unsigned)(bm >> 32), __builtin_amdgcn_mbcnt_lo((unsigned)bm, 0u));
            if (sel && (pos < 256 || !idx_out)) {
                if (idx_out) idx_out[pos] = (unsigned short)ix[i];
                else { const unsigned kk = key[i]; *(LAS unsigned*)(qb + 4 * pos) = (kk & 0x80000000u) ? (kk ^ 0x80000000u) : ~kk; *(LAS unsigned short*)(qb + 4 * CB_CAP + 2 * pos) = (unsigned short)ix[i]; } }
            base += (unsigned)__builtin_popcountll(bm); }
    } else
#pragma unroll
    for (int i = 0; i < NE; ++i) { const unsigned km = key[i] & kmask; const bool v = (vmask >> i) & 1u;
        const bool inb = v && km == kval;
        const unsigned long long bi = __ballot(inb);
        const unsigned rk = bbin + __builtin_amdgcn_mbcnt_hi((unsigned)(bi >> 32), __builtin_amdgcn_mbcnt_lo((unsigned)bi, 0u));
        bbin += (unsigned)__builtin_popcountll(bi);
        const bool sel = (v && km > kval) || (inb && rk < need);
        const unsigned long long bm = __ballot(sel);
        const unsigned pos = base + __builtin_amdgcn_mbcnt_hi((unsigned)(bm >> 32), __builtin_amdgcn_mbcnt_lo((unsigned)bm, 0u));
        if (sel && (pos < 256 || !idx_out)) {
            if (idx_out) idx_out[pos] = (unsigned short)ix[i];
            else { const unsigned kk = key[i]; *(LAS unsigned*)(qb + 4 * pos) = (kk & 0x80000000u) ? (kk ^ 0x80000000u) : ~kk; *(LAS unsigned short*)(qb + 4 * CB_CAP + 2 * pos) = (unsigned short)ix[i]; } }
        base += (unsigned)__builtin_popcountll(bm); }
    LDS_WAIT();
    kept = (int)base;
    return key_to_float(kval);
}

typedef float f32x16 __attribute__((ext_vector_type(16)));
__device__ __forceinline__ void ix_bload(const bf16_t* sub, int lane, bf16x8 (&bf)[4]) {
#pragma unroll
    for (int ks = 0; ks < 4; ++ks) bf[ks] = *(const bf16x8*)(sub + (ks * 64 + lane) * 8);
}
__device__ __forceinline__ f32x16 ix_mma(const bf16x8 (&af)[4], const bf16x8 (&bf)[4]) {
    f32x16 acc = {};
#pragma unroll
    for (int ks = 0; ks < 4; ++ks) acc = __builtin_amdgcn_mfma_f32_32x32x16_bf16(af[ks], bf[ks], acc, 0, 0, 0);
    return acc;
}
__device__ __forceinline__ void ix_unit(const Frame& F, const IxArgs& A, int b, int qg) {
    const int lane = F.lane, w = F.wave, rho = lane & 31, hf = lane >> 5;
    const int t0 = 32 * qg + 4 * w;
    const int qq = 2 * ((rho >> 2) & 1) + (rho >> 4), hh = 4 * ((rho >> 3) & 1) + (rho & 3);
    bf16x8 af[4];
    { const bf16_t* p = A.IQ + ((size_t)b * SEQ + t0 + qq) * 512 + hh * 64 + 8 * hf;
#pragma unroll
      for (int ks = 0; ks < 4; ++ks) af[ks] = *(const bf16x8*)(p + 16 * ks); }
    float wv[2][8];
#pragma unroll
    for (int a = 0; a < 2; ++a) { const float* p = A.IW + ((size_t)b * SEQ + t0 + 2 * hf + a) * 8; const f32x4 x = *(const f32x4*)p, y = *(const f32x4*)(p + 4);
        wv[a][0] = x[0]; wv[a][1] = x[1]; wv[a][2] = x[2]; wv[a][3] = x[3]; wv[a][4] = y[0]; wv[a][5] = y[1]; wv[a][6] = y[2]; wv[a][7] = y[3]; }
    float tau0 = -INFINITY, tau1 = -INFINITY; int cnt0 = 0, cnt1 = 0; bool est = true;
    const int lim0 = 16 + t0 + 2 * hf, lim1 = lim0 + 1;
    const int nsub = ((16 + t0 + 3) >> 5) + 1;
    LAS unsigned char* candw = F.lds + IX_CAND + w * 4 * IX_QB;
    LAS unsigned char* cb0 = candw + (2 * hf) * IX_QB; LAS unsigned char* cb1 = cb0 + IX_QB;
    LAS unsigned* hist = (LAS unsigned*)(F.lds + IX_HIST + w * 1024);
    const bf16_t* ikc_b = A.IKC + (size_t)b * IKC_SUBS * 2048;
#define IX_PROCESS(cur, k_) do { \
        float sc0 = 0.f, sc1 = 0.f; \
        _Pragma("unroll") for (int c = 0; c < 8; ++c) { sc0 = vfma(vmax0(cur[c]), wv[0][c], sc0); sc1 = vfma(vmax0(cur[8 + c]), wv[1][c], sc1); } \
        const int j = 32 * (k_) + rho; \
        const bool p0 = (sc0 > tau0) && (j <= lim0), p1 = (sc1 > tau1) && (j <= lim1); \
        const unsigned long long m0 = __ballot(p0), m1 = __ballot(p1); \
        if ((m0 | m1) != 0ull) { \
            const unsigned lm = (1u << rho) - 1u; \
            { const unsigned mine = hf ? (unsigned)(m0 >> 32) : (unsigned)m0; const int pos = cnt0 + __popc(mine & lm); \
              if (p0) { *(LAS unsigned*)(cb0 + 4 * pos) = __float_as_uint(sc0); *(LAS unsigned short*)(cb0 + 4 * CB_CAP + 2 * pos) = (unsigned short)j; } cnt0 += __popc(mine); } \
            { const unsigned mine = hf ? (unsigned)(m1 >> 32) : (unsigned)m1; const int pos = cnt1 + __popc(mine & lm); \
              if (p1) { *(LAS unsigned*)(cb1 + 4 * pos) = __float_as_uint(sc1); *(LAS unsigned short*)(cb1 + 4 * CB_CAP + 2 * pos) = (unsigned short)j; } cnt1 += __popc(mine); } \
              \
            if (__ballot(cnt0 > CB_CAP - 32 || cnt1 > CB_CAP - 32) != 0ull) { \
                _Pragma("unroll 1") for (int q = 0; q < 4; ++q) { const int qc = __builtin_amdgcn_readlane((q & 1) ? cnt1 : cnt0, (q >> 1) * 32); \
                    if (qc > CB_CAP - 32) { int kept_; unsigned need_ = 256u; \
                        if (est && __builtin_amdgcn_readlane(__float_as_int((q & 1) ? tau1 : tau0), (q >> 1) * 32) == (int)0xff800000) {     \
                            const unsigned r_ = (unsigned)((512 * qc) / (17 + t0 + q)) + 1u; need_ = r_ < 256u ? (r_ < 24u ? 24u : r_) : 256u; } \
                        const float nt = topk_select(candw + q * IX_QB, qc, hist, lane, nullptr, kept_, need_); \
                        if (hf == (q >> 1)) { if (q & 1) { tau1 = nt; cnt1 = kept_; } else { tau0 = nt; cnt0 = kept_; } } } } } \
        } } while (0)
#pragma unroll 1
    for (int attempt = 0; attempt < 2; ++attempt) {
    tau0 = -INFINITY; tau1 = -INFINITY; cnt0 = 0; cnt1 = 0;
    bf16x8 bA[4], bB[4]; f32x16 accA, accB;
    const unsigned char* ikc_l = (const unsigned char*)ikc_b + 16 * lane; const int slast = nsub - 1;
    ix_bload(ikc_b, lane, bA); ix_bload(ikc_b + (size_t)(slast < 1 ? slast : 1) * 2048, lane, bB);
    accA = ix_mma(af, bA); accB = ix_mma(af, bB);
    asm volatile("s_nop 15\n\ts_nop 7" : "+v"(accA), "+v"(accB));
#define IX_GLD4(B, sidx) do { const unsigned char* p_ = ikc_l + (size_t)((sidx) < slast ? (sidx) : slast) * 4096; \
        asm volatile("global_load_dwordx4 %0, %4, off\n\tglobal_load_dwordx4 %1, %4, off offset:1024\n\tglobal_load_dwordx4 %2, %4, off offset:2048\n\tglobal_load_dwordx4 %3, %4, off offset:3072" \
                     : "=&v"(B[0]), "=&v"(B[1]), "=&v"(B[2]), "=&v"(B[3]) : "v"(p_) : "memory"); } while (0)
#pragma unroll 1
    for (int k = 0; k < nsub; k += 2) {
        bf16x8 nA[4], nB[4];
        IX_GLD4(nA, k + 2); IX_GLD4(nB, k + 3);
        IX_PROCESS(accA, k);
        if (k + 1 < nsub) IX_PROCESS(accB, k + 1);
        asm volatile("s_waitcnt vmcnt(0)" : "+v"(nA[0]), "+v"(nA[1]), "+v"(nA[2]), "+v"(nA[3]), "+v"(nB[0]), "+v"(nB[1]), "+v"(nB[2]), "+v"(nB[3]) :: "memory");
        accA = ix_mma(af, nA); accB = ix_mma(af, nB);
        asm volatile("s_nop 15\n\ts_nop 7" : "+v"(accA), "+v"(accB));
    }
    { int short_ = 0;
#pragma unroll
      for (int q = 0; q < 4; ++q) { const int n_ = __builtin_amdgcn_readlane((q & 1) ? cnt1 : cnt0, (q >> 1) * 32), nt_ = 17 + t0 + q; short_ |= (n_ < (nt_ < 256 ? nt_ : 256)) ? 1 : 0; }
      if (!short_) break;
      est = false; }
    }
#undef IX_GLD4
#undef IX_PROCESS
#pragma unroll 1
    for (int q = 0; q < 4; ++q) { const size_t row = (size_t)b * SEQ + t0 + q; unsigned short* io = A.IDX + row * 256; const int n = __builtin_amdgcn_readlane((q & 1) ? cnt1 : cnt0, (q >> 1) * 32);
        LAS unsigned char* qb = candw + q * IX_QB;
        if (n > 256) { int k_; if (n <= 576) (void)topk_select<9>(qb, n, hist, lane, io, k_); else (void)topk_select<CB_CAP / 64>(qb, n, hist, lane, io, k_); if (lane == 0) A.CNT[row] = 256; }
        else {
#pragma unroll
            for (int i = 0; i < 4; ++i) { const int e = lane + 64 * i; io[e] = e < n ? *(LAS unsigned short*)(qb + 4 * CB_CAP + 2 * e) : (unsigned short)0; }
            if (lane == 0) A.CNT[row] = n; } }
    LDS_WAIT();
}

constexpr int AT_VB = 0, AT_IDX = 131072, AT_END = 131072 + 8 * 512;
static_assert(AT_END <= LDSCTL_OFF && IX_END <= LDSCTL_OFF, "LDS maps");
struct AtArgs { const bf16_t* AQ; const unsigned char *KN, *VV; bf16_t* OA; const unsigned short* IDX; const int* CNT; const float* GQ; bf16_t* DUMMY; };
typedef __bf16 bf16x2_t __attribute__((ext_vector_type(2)));
__device__ __forceinline__ bf16x8 fp8x8_to_bf16(unsigned d0, unsigned d1) {
    u32x4 o; o.x = __builtin_bit_cast(unsigned, __builtin_amdgcn_cvt_scalef32_pk_bf16_fp8(d0, 1.0f, false)); o.y = __builtin_bit_cast(unsigned, __builtin_amdgcn_cvt_scalef32_pk_bf16_fp8(d0, 1.0f, true));
    o.z = __builtin_bit_cast(unsigned, __builtin_amdgcn_cvt_scalef32_pk_bf16_fp8(d1, 1.0f, false)); o.w = __builtin_bit_cast(unsigned, __builtin_amdgcn_cvt_scalef32_pk_bf16_fp8(d1, 1.0f, true));
    return __builtin_bit_cast(bf16x8, o);
}
__device__ __forceinline__ int vswz(int rho) { return ((rho & 3) | (((rho >> 3) & 1) << 2)) << 1; }
__device__ __forceinline__ s16x4 tr_read(LAS unsigned char* p) { typedef short v4i16 __attribute__((ext_vector_type(4))); return __builtin_bit_cast(s16x4, __builtin_amdgcn_ds_read_tr16_b64_v4i16((LAS v4i16*)p)); }

struct AtPre { u32x2 idxv; int n; u32x4 qraw[4]; };
__device__ __forceinline__ void at_preload(AtPre& P, const AtArgs& A, int b, int kvh, int t, int lane) {
    const size_t row = (size_t)b * SEQ + t; const int g = lane >> 4, hd = lane & 3;
    P.n = A.CNT[row]; P.idxv = *(const u32x2*)(A.IDX + row * 256 + 4 * lane);
    const bf16_t* qp = A.AQ + row * 1024 + (size_t)(4 * kvh + hd) * 128 + 32 * g;
#pragma unroll
    for (int ks = 0; ks < 4; ++ks) P.qraw[ks] = *(const u32x4*)(qp + 8 * ks);
}
__device__ __forceinline__ void at_query(const AtArgs& A, const AtPre& P, AtPre& PN, bool has_next, int t_next, int kvh_next, LAS unsigned char* vb, LAS unsigned char* idxl, int b, int kvh, int t, int lane) {
    const int r = lane & 15, g = lane >> 4, hd = lane & 3;
    const size_t row = (size_t)b * SEQ + t;
    const int n = P.n;
    *(LAS u32x2*)(idxl + 8 * lane) = P.idxv;
    if (has_next) at_preload(PN, A, b, kvh_next, t_next, lane);
    long qf[4]; float ssq = 0.f;
    { const float* gp = A.GQ + 32 * g;
#pragma unroll
      for (int ks = 0; ks < 4; ++ks) { const u32x4 raw = P.qraw[ks]; const f32x4 g0 = *(const f32x4*)(gp + 8 * ks), g1 = *(const f32x4*)(gp + 8 * ks + 4);
          const float x0 = bflo(raw.x), x1 = bfhi(raw.x), x2 = bflo(raw.y), x3 = bfhi(raw.y), x4 = bflo(raw.z), x5 = bfhi(raw.z), x6 = bflo(raw.w), x7 = bfhi(raw.w);
          ssq += (x0 * x0 + x1 * x1) + (x2 * x2 + x3 * x3) + (x4 * x4 + x5 * x5) + (x6 * x6 + x7 * x7);
          const unsigned lo = pack4_fp8(x0 * g0[0], x1 * g0[1], x2 * g0[2], x3 * g0[3]), hi = pack4_fp8(x4 * g1[0], x5 * g1[1], x6 * g1[2], x7 * g1[3]);
          qf[ks] = (long)(((unsigned long long)hi << 32) | lo); } }
    ssq += __shfl_xor(ssq, 16); ssq += __shfl_xor(ssq, 32);
    const float qs = (__builtin_amdgcn_rsqf(ssq * (1.f / 128.f) + EPS)) * (0.08838834764831845f * LOG2E);
    const float slope2 = __builtin_amdgcn_exp2f(-(float)(4 * kvh + hd + 1)) * LOG2E;
    const unsigned char* vbase = A.VV + (size_t)(b * 2 + kvh) * NKEY * 128;
    LDS_WAIT();
    f32x4 sc[16];
    unsigned idx_r = (unsigned)(uintptr_t)idxl + 2 * r, idx_g = (unsigned)(uintptr_t)idxl + 8 * g;
    asm volatile("" : "+v"(idx_r), "+v"(idx_g));
    {
        u32x4 kr[8][2];
        const int krl = lane >> 3, kch = lane & 7;
        unsigned idx_k = (unsigned)(uintptr_t)idxl + 4 * krl; asm volatile("" : "+v"(idx_k));
        const unsigned char* kb0 = A.KN + (size_t)(b * 2 + kvh) * NKEY * 128 + 16 * kch;
        unsigned kw0 = (unsigned)(uintptr_t)vb + 8192 + (2 * krl) * 128 + 16 * (kch ^ krl);
        unsigned kw1 = kw0 + 128;
        unsigned kr0 = (unsigned)(uintptr_t)vb + 8192 + r * 128 + 16 * ((2 * g) ^ ((r >> 1) & 7));
        asm volatile("" : "+v"(kw0), "+v"(kw1), "+v"(kr0));
#define AT_KLOAD(dst, i) do { const unsigned iab_ = *(LAS unsigned*)(uintptr_t)(idx_k + 32 * (i)), ia_ = iab_ & 0xffffu, ib_ = iab_ >> 16; \
            dst[0] = *(const u32x4*)(kb0 + (size_t)ia_ * 128); dst[1] = *(const u32x4*)(kb0 + (size_t)ib_ * 128); } while (0)
#define AT_KMMA(i) do { const u32x4 f0_ = *(LAS u32x4*)(uintptr_t)(kr0 + ((i) & 3) * 2048), f1_ = *(LAS u32x4*)(uintptr_t)((kr0 ^ 16) + ((i) & 3) * 2048); f32x4 acc = {0.f, 0.f, 0.f, 0.f}; \
            acc = __builtin_amdgcn_mfma_f32_16x16x32_fp8_fp8((long)(((unsigned long long)f0_.y << 32) | f0_.x), qf[0], acc, 0, 0, 0); \
            acc = __builtin_amdgcn_mfma_f32_16x16x32_fp8_fp8((long)(((unsigned long long)f0_.w << 32) | f0_.z), qf[1], acc, 0, 0, 0); \
            acc = __builtin_amdgcn_mfma_f32_16x16x32_fp8_fp8((long)(((unsigned long long)f1_.y << 32) | f1_.x), qf[2], acc, 0, 0, 0); \
            acc = __builtin_amdgcn_mfma_f32_16x16x32_fp8_fp8((long)(((unsigned long long)f1_.w << 32) | f1_.z), qf[3], acc, 0, 0, 0); sc[i] = acc; } while (0)
#pragma unroll
        for (int i = 0; i < 8; ++i) AT_KLOAD(kr[i], i);
#pragma unroll
        for (int i = 0; i < 16; ++i) {
            *(LAS u32x4*)(uintptr_t)(kw0 + (i & 3) * 2048) = kr[i & 7][0]; *(LAS u32x4*)(uintptr_t)(kw1 + (i & 3) * 2048) = kr[i & 7][1];
            if (i + 8 < 16) AT_KLOAD(kr[i & 7], i + 8);
            if (i >= 1) AT_KMMA(i - 1); }
        AT_KMMA(15);
#undef AT_KLOAD
#undef AT_KMMA
    }
    __builtin_amdgcn_sched_barrier(0);
    const int vrl = lane >> 3, vch = lane & 7;
    u32x4 vd[3][4];
    unsigned idx_v = (unsigned)(uintptr_t)idxl; asm volatile("" : "+v"(idx_v));
    unsigned vsl[4];
#pragma unroll
    for (int c4 = 0; c4 < 4; ++c4) { const int rho = 8 * c4 + vrl; vsl[c4] = 2u * (unsigned)(16 * ((rho & 7) >> 2) + 4 * (rho >> 3) + (rho & 3)); }
#define AT_VLOAD(dst, kk) do { _Pragma("unroll") for (int c4 = 0; c4 < 4; ++c4) { const unsigned iv_ = *(LAS unsigned short*)(uintptr_t)(idx_v + 64 * (kk) + vsl[c4]); \
        dst[c4] = *(const u32x4*)(vbase + (size_t)iv_ * 128 + 16 * vch); } } while (0)
    AT_VLOAD(vd[0], 7); AT_VLOAD(vd[1], 6); AT_VLOAD(vd[2], 5);
    const int rep = (lane >> 2) & 3;
    float mx = -INFINITY; const float qpos = (float)(16 + t); int nrel = n - 4 * g - 16 * rep; asm volatile("" : "+v"(nrel));
    unsigned idx_gr = idx_g + 32 * rep; asm volatile("" : "+v"(idx_gr));
    float yv[4][4];
    { const bool m1 = rep == 1, m2 = rep == 2, m3 = rep == 3;
#pragma unroll
      for (int j = 0; j < 4; ++j) { const u32x2 iv = *(LAS u32x2*)(uintptr_t)(idx_gr + 128 * j);
        float s0 = sc[4 * j][0], s1 = sc[4 * j][1], s2 = sc[4 * j][2], s3 = sc[4 * j][3];
        s0 = m1 ? sc[4 * j + 1][0] : s0; s1 = m1 ? sc[4 * j + 1][1] : s1; s2 = m1 ? sc[4 * j + 1][2] : s2; s3 = m1 ? sc[4 * j + 1][3] : s3;
        s0 = m2 ? sc[4 * j + 2][0] : s0; s1 = m2 ? sc[4 * j + 2][1] : s1; s2 = m2 ? sc[4 * j + 2][2] : s2; s3 = m2 ? sc[4 * j + 2][3] : s3;
        s0 = m3 ? sc[4 * j + 3][0] : s0; s1 = m3 ? sc[4 * j + 3][1] : s1; s2 = m3 ? sc[4 * j + 3][2] : s2; s3 = m3 ? sc[4 * j + 3][3] : s3;
        const float d0 = qpos - (float)(iv.x & 0xffffu), d1 = qpos - (float)(iv.x >> 16), d2 = qpos - (float)(iv.y & 0xffffu), d3 = qpos - (float)(iv.y >> 16);
        float y0 = s0 * qs - slope2 * d0, y1 = s1 * qs - slope2 * d1, y2 = s2 * qs - slope2 * d2, y3 = s3 * qs - slope2 * d3;
        y0 = 64 * j + 0 < nrel ? y0 : -INFINITY; y1 = 64 * j + 1 < nrel ? y1 : -INFINITY; y2 = 64 * j + 2 < nrel ? y2 : -INFINITY; y3 = 64 * j + 3 < nrel ? y3 : -INFINITY;
        yv[j][0] = y0; yv[j][1] = y1; yv[j][2] = y2; yv[j][3] = y3; mx = fmaxf(fmaxf(fmaxf(y0, y1), fmaxf(y2, y3)), mx); } }
    mx = fmaxf(mx, dpp_f(mx, 0x128)); mx = fmaxf(mx, dpp_f(mx, 0x124));
    mx = fmaxf(mx, __shfl_xor(mx, 16)); mx = fmaxf(mx, __shfl_xor(mx, 32));
    float l = 0.f; unsigned pd[4];
#pragma unroll
    for (int j = 0; j < 4; ++j) {
        const float p0 = __builtin_amdgcn_exp2f(yv[j][0] - mx), p1 = __builtin_amdgcn_exp2f(yv[j][1] - mx), p2 = __builtin_amdgcn_exp2f(yv[j][2] - mx), p3 = __builtin_amdgcn_exp2f(yv[j][3] - mx);
        l += (p0 + p1) + (p2 + p3);
        pd[j] = pack4_fp8(p0 * 256.f, p1 * 256.f, p2 * 256.f, p3 * 256.f); }
    l += dpp_f(l, 0x128); l += dpp_f(l, 0x124);
    l += __shfl_xor(l, 16); l += __shfl_xor(l, 32);
    long pf[8];
#pragma unroll
    for (int j = 0; j < 4; ++j) {
        const unsigned t1 = (unsigned)__builtin_amdgcn_update_dpp(0, (int)pd[j], 0x104, 0xf, 0xf, true), t2 = (unsigned)__builtin_amdgcn_update_dpp(0, (int)pd[j], 0x108, 0xf, 0xf, true),
                       t3 = (unsigned)__builtin_amdgcn_update_dpp(0, (int)pd[j], 0x10C, 0xf, 0xf, true);
        pf[2 * j] = (long)(((unsigned long long)t1 << 32) | pd[j]); pf[2 * j + 1] = (long)(((unsigned long long)t3 << 32) | t2); }
    f32x4 oa[8];
#pragma unroll
    for (int m = 0; m < 8; ++m) oa[m] = (f32x4){0.f, 0.f, 0.f, 0.f};
    const int trow = 8 * g + ((lane & 15) >> 1);
    const unsigned tr0 = (unsigned)(uintptr_t)vb + trow * 128 + 16 * ((trow >> 1) & 7) + 8 * (lane & 1);
    unsigned trm[8];
#pragma unroll
    for (int m = 0; m < 8; ++m) trm[m] = tr0 ^ (16u * m);
    unsigned vw[4];
#pragma unroll
    for (int c4 = 0; c4 < 4; ++c4) { const int rho = 8 * c4 + vrl; vw[c4] = (unsigned)(uintptr_t)vb + rho * 128 + 16 * (vch ^ ((rho >> 1) & 7)); }
    unsigned vm = 0;
#pragma unroll
    for (int kk = 0; kk < 8; ++kk) vm |= (__ballot((lane & 15) < 4 && pf[kk] != 0) != 0ull) ? (1u << kk) : 0u;
#pragma unroll
    for (int s = 0; s < 8; ++s) { const int kk = 7 - s; const bool on = (vm >> kk) & 1u;
        if (on) {
#pragma unroll
            for (int c4 = 0; c4 < 4; ++c4) *(LAS u32x4*)(uintptr_t)(vw[c4] + (s & 1) * 4096) = vd[s % 3][c4]; }
        if (s + 3 < 8 && ((vm >> (kk - 3)) & 1u)) AT_VLOAD(vd[s % 3], kk - 3);
        if (on) {
#pragma unroll
            for (int m = 0; m < 8; ++m) {
                typedef int v2i32 __attribute__((ext_vector_type(2)));
                const v2i32 t = __builtin_amdgcn_ds_read_tr8_b64_v2i32((LAS v2i32*)(uintptr_t)(trm[m] + (s & 1) * 4096));
                oa[m] = __builtin_amdgcn_mfma_f32_16x16x32_fp8_fp8((long)(((unsigned long long)(unsigned)t[1] << 32) | (unsigned)t[0]), pf[kk], oa[m], 0, 0, 0); } }
    }
#undef AT_VLOAD
    const float inv = (1.f / 256.f) * fast_rcp(l);
    if (r < 4) { bf16_t* op = A.OA + row * 1024 + (size_t)(4 * kvh + r) * 128 + 4 * g;
#pragma unroll
        for (int m = 0; m < 8; ++m) { u32x2 o; o.x = cvt_pk_bf16(oa[m][0] * inv, oa[m][1] * inv); o.y = cvt_pk_bf16(oa[m][2] * inv, oa[m][3] * inv); *(u32x2*)(op + 16 * m) = o; } }
    LDS_WAIT();
}
__device__ __forceinline__ void at_phase(const Frame& F, const AtArgs& A) {
    const int xg = F.vcu >> 5, b = xg >> 1, j = 32 * (xg & 1) + (F.vcu & 31);
    LAS unsigned char* vb = F.lds + AT_VB + F.wave * 16384; LAS unsigned char* idxl = F.lds + AT_IDX + F.wave * 512;
#ifndef AT_REP
#define AT_REP 1
#endif
#define AT_T(qq) (64 * (64 * ((qq) >> 4) + j) + 8 * F.wave + (((qq) >> 1) & 7))
    for (int rep = AT_REP; rep > 0; --rep) {
        AtArgs A2 = A; if (rep > 1) A2.OA = A.DUMMY;
        AtPre Pa, Pb; at_preload(Pa, A2, b, 0, AT_T(0), F.lane);
        for (int qq = 0; qq < 32; qq += 2) {
            at_query(A2, Pa, Pb, true, AT_T(qq + 1), 1, vb, idxl, b, 0, AT_T(qq), F.lane);
            at_query(A2, Pb, Pa, qq + 2 < 32, AT_T((qq + 2) & 31), 0, vb, idxl, b, 1, AT_T(qq + 1), F.lane); } }
#undef AT_T
}

struct Args { const float* in[11]; float* out; unsigned char* ws; int ph_lo, ph_hi, li, pad; };
__global__ void __launch_bounds__(NWAVES * 64, 2) hyb_fwd(Args args) {
    extern __shared__ __attribute__((aligned(16))) unsigned char lds_raw[];
    Frame F;
    F.lds = (LAS unsigned char*)lds_raw;
    volatile LAS unsigned* MISC = (volatile LAS unsigned*)(F.lds + MISC_OFF);
    F.tid = threadIdx.x; F.lane = F.tid & 63; F.wave = __builtin_amdgcn_readfirstlane(F.tid >> 6);
    F.G = gridDim.x; { const int bx = blockIdx.x; F.vcu = (F.G % 8 == 0) ? (bx % 8) * (F.G / 8) + bx / 8 : bx; }
    unsigned char* ws = args.ws;
    gu32* ctl = (gu32*)(ws + WS_CTL);
    for (int u = F.tid; u < (LDS_BYTES - LDSCTL_OFF) / 4; u += NWAVES * 64) ((LAS unsigned*)(F.lds + LDSCTL_OFF))[u] = 0u;
    __syncthreads();
    const int lo = args.ph_lo, hi = args.ph_hi; const bool multi = (hi - lo) > 1;
    XcdBarrier bar; bar.bar = (unsigned*)(ctl + CW_BAR); bar.x = 0; bar.st = nullptr;
    if (multi) bar = xcd_barrier_post((unsigned*)(ctl + CW_BAR), MISC + 8);
#ifndef PHMASK
#define PHMASK 0x7f
#endif
#define IN(k) (((PHMASK >> (k)) & 1) && lo <= (k) && (k) < hi)
#define GRID_BAR(k) do { if (IN(k) && IN((k) + 1)) xcd_barrier(bar); } while (0)
    const float *x = args.in[0], *meta = args.in[1], *norm_g = args.in[2], *w_in = args.in[3], *lb_logits = args.in[4], *r_norm_g = args.in[5], *q_norm_g = args.in[6], *k_norm_g = args.in[7],
                *w_r = args.in[8], *w_a = args.in[9], *w_out = args.in[10];
    unsigned char *W1A8 = ws + WS_W1A8, *W1B8 = ws + WS_W1B8, *WR8 = ws + WS_WR8, *WA8 = ws + WS_WA8, *WO8 = ws + WS_WO8, *XN8 = ws + WS_XN8, *GR8 = ws + WS_GR8, *GA8 = ws + WS_GA8; bf16_t* W1AI = (bf16_t*)(ws + WS_W1AI);
    bf16_t *XN = (bf16_t*)(ws + WS_XN), *RQ = (bf16_t*)(ws + WS_RQ), *RF = (bf16_t*)(ws + WS_RF), *RV = (bf16_t*)(ws + WS_RV), *AQ = (bf16_t*)(ws + WS_AQ);
    bf16_t *AK = (bf16_t*)(ws + WS_AK), *AV = (bf16_t*)(ws + WS_AV), *IQ = (bf16_t*)(ws + WS_IQ), *IKC = (bf16_t*)(ws + WS_IKC); unsigned char *KN = ws + WS_KN, *VV = ws + WS_VV;
    float *IW = (float*)(ws + WS_IW), *LB = (float*)(ws + WS_LB), *SLOC = (float*)(ws + WS_SLOC), *DSEG = (float*)(ws + WS_DSEG);
    unsigned short* IDX = (unsigned short*)(ws + WS_IDX); int* CNT = (int*)(ws + WS_CNT);

#ifndef DUP
#define DUP -1
#endif
#define PH0() do { const P0Args a{x, meta, norm_g, w_in, lb_logits, w_r, w_a, w_out, W1A8, W1B8, WR8, WA8, WO8, XN8, W1AI, XN, LB}; p0_prologue(F, a); } while (0)
  \
#define PH1() do { { pg8::TileOrder S; S.init(MROWS, N1AI, F.G, (int)blockIdx.x, 1, XN, W1AI, XN, W1AI);     \
          const pg8::EpiP1 E{RQ, RF, RV, AQ, AK, AV, IQ, IKC, IW, 18, 1.f}; \
          pg8::gemm_phase<pg8::EpiP1, pg8::TileOrder, true, true, false>(F.lds, 1024, S, E); } \
        { pg8::TileOrder S; S.init(MROWS, N1A8, F.G, (int)blockIdx.x, 1, (const bf16_t*)XN8, (const bf16_t*)W1A8, (const bf16_t*)XN8, (const bf16_t*)W1A8); \
          const pg8::EpiP1 E{RQ, RF, RV, AQ, AK, AV, IQ, IKC, IW, 0, ZSCALE}; \
          pg8::gemm_phase<pg8::EpiP1, pg8::TileOrder, true, true, true>(F.lds, 512, S, E); } } while (0)
#ifndef P2MASK
#define P2MASK 7
#endif
#define PH2() do { \
        if (P2MASK & 1) { const HgArgs a{RQ, RF, RV, RQ, LB, r_norm_g, SLOC, DSEG}; for (int rep = H1_REP; rep > 0; --rep) h1_unit(F, a); } \
        if (P2MASK & 2) { const KnArgs a{AK, AV, k_norm_g, KN, VV}; for (int rep = KN_REP; rep > 0; --rep) knorm_share(F, a); } \
        if (P2MASK & 4) { const IxArgs a{IQ, IKC, IW, IDX, CNT}; \
          for (int ub4 = 0; ub4 < 4 * IX_REP; ++ub4) { const int ub = (ub4 + (F.wave >> 2)) & 3;     \
            const int v = F.vcu, qg = ub == 0 ? v : ub == 1 ? 255 - v : ub == 2 ? ((v + 128) & 255) : 255 - ((v + 128) & 255); ix_unit(F, a, ub, qg); } } } while (0)
#ifndef P3MASK
#define P3MASK 3
#endif
#ifndef H3_REP
#define H3_REP 1
#endif
#ifndef H1_REP
#define H1_REP 1
#endif
#ifndef KN_REP
#define KN_REP 1
#endif
#ifndef IX_REP
#define IX_REP 1
#endif
#define PH3(ORP, OAP) do { \
        if (P3MASK & 1) { for (int rep = H3_REP; rep > 0; --rep) { const HgArgs a{RQ, RF, RV, rep > 1 ? (bf16_t*)args.out : ORP, LB, r_norm_g, SLOC, DSEG}; h3_unit(F, a); } } \
        __syncthreads(); \
        if (P3MASK & 2) { const AtArgs a{AQ, KN, VV, OAP, IDX, CNT, q_norm_g, (bf16_t*)args.out}; at_phase(F, a); } \
        __syncthreads(); } while (0)
#define PH4() do { pg8::TileOrder S; S.init(NTOK, N1B, F.G, (int)blockIdx.x, 1, (const bf16_t*)XN8, (const bf16_t*)W1B8, (const bf16_t*)XN8, (const bf16_t*)W1B8); \
        const pg8::EpiP4 E{ws}; \
        pg8::gemm_phase<pg8::EpiP4, pg8::TileOrder, true, true, true>(F.lds, 512, S, E); } while (0)
#define PH5() do { pg8::TileOrder S; S.init(NTOK, 1024, F.G, (int)blockIdx.x, 2, (const bf16_t*)GR8, (const bf16_t*)WR8, (const bf16_t*)GA8, (const bf16_t*)WA8); \
        const pg8::EpiP5 E{RF, RV, XN8}; \
        pg8::gemm_phase<pg8::EpiP5, pg8::TileOrder, true, true, true>(F.lds, 512, S, E); } while (0)
#define PH6() do { pg8::TileOrder S; S.init(NTOK, 1024, F.G, (int)blockIdx.x, 1, (const bf16_t*)XN8, (const bf16_t*)WO8, (const bf16_t*)XN8, (const bf16_t*)WO8); \
        const pg8::EpiP6 E{x, args.out}; \
        pg8::gemm_phase<pg8::EpiP6, pg8::TileOrder, true, true, true>(F.lds, 512, S, E); } while (0)

    if (IN(0)) { PH0(); }
    GRID_BAR(0);
    if (IN(1)) { PH1(); }
    GRID_BAR(1);
    if (IN(2)) { PH2(); }
    GRID_BAR(2);
    if (IN(3)) { PH3(RQ, AQ); }
    GRID_BAR(3);
    if (IN(4)) { PH4(); }
    GRID_BAR(4);
    if (IN(5)) { PH5(); }
    GRID_BAR(5);
    if (IN(6)) { PH6(); }
#undef IN
#undef GRID_BAR
}

extern "C" void kernel_launch(void* const* d_in, const int* in_sizes, int n_in, void* d_out, int out_size, void* d_ws, size_t ws_size, hipStream_t stream) {
    static int grid = 0;
    if (grid == 0) {
        if (n_in != 11 || in_sizes[0] != NTOK * DM || out_size != NTOK * DM || ws_size < WS_END) { fprintf(stderr, "kernel_launch: unexpected shapes (n_in %d, in0 %d, out %d, ws %zu); nothing launched\n", n_in, n_in > 0 ? in_sizes[0] : -1, out_size, ws_size); grid = -1; return; }
        int dev = 0, cus = 0, per_cu = 0;
        if (hipGetDevice(&dev) != hipSuccess || hipDeviceGetAttribute(&cus, hipDeviceAttributeMultiprocessorCount, dev) != hipSuccess) { grid = -1; return; }
        if (hipFuncSetAttribute((const void*)hyb_fwd, hipFuncAttributeMaxDynamicSharedMemorySize, LDS_BYTES) != hipSuccess) { fprintf(stderr, "kernel_launch: hipFuncSetAttribute failed\n"); grid = -1; return; }
        if (hipOccupancyMaxActiveBlocksPerMultiprocessor(&per_cu, (const void*)hyb_fwd, NWAVES * 64, LDS_BYTES) != hipSuccess || per_cu < 1) fprintf(stderr, "kernel_launch: occupancy query reports %d\n", per_cu);
        (void)hipGetLastError();
        grid = cus;
        if (grid != 256) fprintf(stderr, "kernel_launch: %d CUs; this kernel's unit maps assume 256\n", grid);
    }
    if (grid < 0) return;
    if (hipMemsetAsync((char*)d_ws + WS_CTL, 0, CTL_ZERO_BYTES, stream) != hipSuccess) return;
    Args a{};
    for (int i = 0; i < 11; ++i) a.in[i] = (const float*)d_in[i];
    a.out = (float*)d_out; a.ws = (unsigned char*)d_ws;
    a.ph_lo = 0; a.ph_hi = 7; a.li = 0;
    hipLaunchKernelGGL(hyb_fwd, dim3(grid), dim3(NWAVES * 64), LDS_BYTES, stream, a);
}
```

```cpp
#include <hip/hip_runtime.h>
#include <cstdio>
#include <cstdint>

#define GAS __attribute__((address_space(1)))
#define LAS __attribute__((address_space(3)))
#define PG8_LAS __attribute__((address_space(3)))
typedef unsigned short bf16_t;
typedef short bf16x8 __attribute__((ext_vector_type(8)));
typedef short s16x4 __attribute__((ext_vector_type(4)));
typedef float f32x4 __attribute__((ext_vector_type(4)));
typedef float f32x2 __attribute__((ext_vector_type(2)));
typedef unsigned u32x4 __attribute__((ext_vector_type(4)));
typedef unsigned u32x2 __attribute__((ext_vector_type(2)));
typedef GAS unsigned gu32;
typedef GAS unsigned long long gu64;
#define RLX_AGENT __ATOMIC_RELAXED, __HIP_MEMORY_SCOPE_AGENT

constexpr int NB = 4, SEQ = 8192, DM = 1024, NTOK = NB * SEQ;
constexpr int MROWS = NTOK + 256;
constexpr int META_ROW0 = NTOK + 48;
constexpr int NKEY = SEQ + 16;
constexpr int IKC_SUBS = (NKEY + 31) / 32;
constexpr int N1A = 5376, N1B = 4096;
constexpr float EPS = 1e-6f;
constexpr float LOG2E = 1.4426950408889634f;
constexpr int C_RQ = 0, C_RF = 1024, C_RI = 2048, C_RG = 3072, C_AQ = 4096, C_AK = 5120, C_AV = 5376, C_AG = 5632, C_IQ = 6656, C_IK = 7168, C_IW = 7232, C_MR = 7240, C_MA = 8264, D_IN = 9288;

constexpr size_t MiB = 1u << 20;
constexpr size_t WS_CTL = 0, CTL_ZERO_BYTES = 32 * 1024;
constexpr size_t WS_W1A8 = 1 * MiB, WS_W1AI = 6 * MiB, WS_W1B8 = 8 * MiB, WS_WR8 = 12 * MiB, WS_WA8 = 13 * MiB, WS_WO8 = 14 * MiB, WS_LB = 26 * MiB;
constexpr size_t WS_IW = 27 * MiB, WS_IKC = 29 * MiB, WS_XN = 34 * MiB, WS_RQ = 99 * MiB, WS_RF = 164 * MiB, WS_RV = 229 * MiB, WS_AQ = 294 * MiB;
constexpr size_t WS_AK = 359 * MiB, WS_AV = 376 * MiB, WS_IQ = 393 * MiB, WS_KN = 426 * MiB, WS_VV = 435 * MiB, WS_SLOC = 444 * MiB, WS_DSEG = 460 * MiB;
constexpr size_t WS_IDX = 461 * MiB, WS_CNT = 477 * MiB, WS_XN8 = 478 * MiB, WS_END = 511 * MiB;
constexpr size_t WS_GR8 = WS_XN, WS_GA8 = WS_XN + 32 * MiB;
constexpr int N1A8 = 4608, N1AI = 768;
constexpr float WSCALE = 32.f, ZSCALE = 1.f / 32.f;
static_assert((size_t)MROWS * 1024 * 2 <= 65 * MiB && (size_t)MROWS * 512 * 2 <= 33 * MiB && (size_t)MROWS * 256 * 2 <= 17 * MiB, "ws map");
static_assert((size_t)NB * 2 * NKEY * 128 <= 9 * MiB && (size_t)NB * IKC_SUBS * 4096 <= 5 * MiB && (size_t)MROWS * 8 * 4 <= 2 * MiB && (size_t)MROWS * 1024 <= 33 * MiB, "ws map");
constexpr int CW_TMO = 0, CW_CODE = 1, CW_BAR = 4096;

__device__ __forceinline__ float bf2f(unsigned v) { return __uint_as_float(v << 16); }
__device__ __forceinline__ float bflo(unsigned v) { return __uint_as_float(v << 16); }
__device__ __forceinline__ float bfhi(unsigned v) { return __uint_as_float(v & 0xffff0000u); }
typedef __bf16 bf16n2 __attribute__((ext_vector_type(2))); typedef float f32n2 __attribute__((ext_vector_type(2)));
__device__ __forceinline__ unsigned cvt_pk_bf16(float lo, float hi) { const f32n2 v = {lo, hi}; return __builtin_bit_cast(unsigned, __builtin_convertvector(v, bf16n2)); }
__device__ __forceinline__ unsigned pack4_fp8(float a, float b, float c, float d) { int r = __builtin_amdgcn_cvt_pk_fp8_f32(a, b, 0, false); r = __builtin_amdgcn_cvt_pk_fp8_f32(c, d, r, true); return (unsigned)r; }
__device__ __forceinline__ float fast_exp(float x) { return __builtin_amdgcn_exp2f(x * LOG2E); }
__device__ __forceinline__ float fast_rcp(float x) { return __builtin_amdgcn_rcpf(x); }
__device__ __forceinline__ float sigmoid_f(float v) { return fast_rcp(1.f + fast_exp(-v)); }
__device__ __forceinline__ float silu_f(float v) { return v * sigmoid_f(v); }
__device__ __forceinline__ float wave_sum(float v) {
#pragma unroll
    for (int o = 1; o < 64; o <<= 1) v += __shfl_xor(v, o);
    return v;
}

__device__ __forceinline__ void grid_wait_hook(unsigned* pbar, unsigned lds_addr);
namespace pg8 {
constexpr int BM = 256, BK = 64, HALF = 128, HTB = HALF * BK * 2, STAGE_BYTES = 8 * HTB, NXCD = 8, WGM = 8;
__host__ __device__ __forceinline__ int lds_byte(int r, int c) { const int st = (r >> 4) * 2 + (c >> 5), rr = r & 15, cc = c & 31, ob = rr * 64 + cc * 2; return st * 1024 + (ob ^ (((ob >> 9) & 1) << 5)); }
__host__ __device__ __forceinline__ void stage_rc(int b, int& R, int& C) { const int st = b / 1024, sb = b % 1024, swz = sb ^ (((sb >> 9) & 1) << 5); R = (st >> 1) * 16 + swz / 64; C = (st & 1) * 32 + (swz % 64) / 2; }
__host__ __device__ __forceinline__ int perm32(int rho) { const int n = rho >> 4, i = rho & 15; return 8 * (i >> 2) + 4 * n + (i & 3); }

typedef int v8i32 __attribute__((ext_vector_type(8)));
__device__ __forceinline__ v8i32 pg8_cat(bf16x8 lo, bf16x8 hi) { const u32x4 a = __builtin_bit_cast(u32x4, lo), b = __builtin_bit_cast(u32x4, hi); return (v8i32){(int)a.x, (int)a.y, (int)a.z, (int)a.w, (int)b.x, (int)b.y, (int)b.z, (int)b.w}; }
__device__ __forceinline__ void pg8_mfma8(f32x4& acc, v8i32 a, v8i32 b, int scale) {
    asm volatile("v_mfma_scale_f32_16x16x128_f8f6f4 %0, %1, %2, %0, %3, %3 op_sel_hi:[0,0,0]" : "+v"(acc) : "v"(a), "v"(b), "v"(scale)); }
typedef unsigned long long u64n2 __attribute__((ext_vector_type(2)));
__device__ __forceinline__ void zero_frag(f32x4& a) { u64n2 t; asm volatile("v_mov_b64 %0, 0" : "=v"(t.x)); asm volatile("v_mov_b64 %0, 0" : "=v"(t.y)); a = __builtin_bit_cast(f32x4, t); }
struct Unit { int pm, pn; const bf16_t* A; const bf16_t* Bt; int aux; };

struct TileOrder {
    int nM, nN, nwg, G, c, rep; const bf16_t* A[2]; const bf16_t* Bt[2]; unsigned* pend = nullptr;
    __device__ __forceinline__ void init(int M, int N, int G_, int c_, int rep_, const bf16_t* A0, const bf16_t* B0, const bf16_t* A1, const bf16_t* B1) {
        nM = M / BM; nN = N / BM; nwg = nM * nN; G = G_; c = c_; rep = rep_; A[0] = A0; A[1] = A1; Bt[0] = B0; Bt[1] = B1; }
    __device__ __forceinline__ bool next(int ii, Unit& u) const {
        const int i = (rep == 2) ? (ii >> 1) : ii, a = (rep == 2) ? (ii & 1) : 0;
        const long L = (long)i * G + c; if (L >= nwg) return false;
        int wgid = (int)L; { const int q = nwg / NXCD, r = nwg % NXCD, xcd = wgid % NXCD, off = wgid / NXCD; wgid = (xcd < r ? xcd * (q + 1) : r * (q + 1) + (xcd - r) * q) + off; }
        const int nig = WGM * nN, gid = wgid / nig, fm = gid * WGM, gsz = (nM - fm) < WGM ? (nM - fm) : WGM;
        u.pm = fm + ((wgid % nig) % gsz); u.pn = (wgid % nig) / gsz; u.aux = a; u.A = a ? A[1] : A[0]; u.Bt = a ? Bt[1] : Bt[0]; return true;
    }
    __device__ __forceinline__ void a_ready(const Unit&) const {}
    __device__ __forceinline__ void done(const Unit&) const {}
};


struct EpiP1 {
    static constexpr bool ZEROES = false; static constexpr bool PERM = true, AFTER_DRAIN = false;
    __device__ __forceinline__ int vm_ops(const Unit& u) const { return (u.pn + pn_off) < 20 ? 16 : 0; }
    __device__ __forceinline__ bool keep(const Unit&) const { return false; }
    bf16_t *RQ, *RF, *RV, *AQ, *AK, *AV, *IQ, *IKC; float* IW; int pn_off; float zs;
    __device__ __forceinline__ void operator()(const f32x4 (&acc)[2][2][4][2], const Unit& u, int wr, int wc, int fr, int fq) const {
        const int pn = u.pn + pn_off, row0 = u.pm * BM + wr * 64 + fr;
        if ((pn >= 12 && pn < 16) || pn < 4 || (pn >= 8 && pn < 12)) {
            const bool act = pn < 4; unsigned char* const AQ = (unsigned char*)RQ + (act ? (size_t)0 : pn < 12 ? (size_t)(WS_RV - WS_RQ) : (size_t)(WS_AQ - WS_RQ));
            const int col0 = (pn & 3) * 256 + wc * 32 + 8 * fq;
#pragma unroll
            for (int ai = 0; ai < 2; ++ai)
#pragma unroll
                for (int m = 0; m < 4; ++m)
#pragma unroll
                    for (int bj = 0; bj < 2; ++bj) { f32x4 v0 = acc[ai][bj][m][0] * zs, v1 = acc[ai][bj][m][1] * zs;
                        if (act) {
#pragma unroll
                            for (int e = 0; e < 4; ++e) { v0[e] = silu_f(v0[e]) * 0.08838834764831845f; v1[e] = silu_f(v1[e]) * 0.08838834764831845f; } }
                        u32x2 w8; w8.x = pack4_fp8(v0[0], v0[1], v0[2], v0[3]); w8.y = pack4_fp8(v1[0], v1[1], v1[2], v1[3]);
                        *(u32x2*)(AQ + (size_t)(row0 + ai * HALF + m * 16) * 1024 + col0 + bj * HALF) = w8; }
        } else if (pn < 20) {
            bf16_t* base; int ld, colt; bool act = false;
            if (pn < 4) { base = RQ; ld = 1024; colt = pn * 256; act = true; }
            else if (pn < 8) { base = RF; ld = 1024; colt = (pn - 4) * 256; }
            else if (pn < 12) { base = RV; ld = 1024; colt = (pn - 8) * 256; }
            else if (pn < 16) { base = AQ; ld = 1024; colt = (pn - 12) * 256; }
            else if (pn == 16) { base = AK; ld = 256; colt = 0; }
            else if (pn == 17) { base = AV; ld = 256; colt = 0; }
            else { base = IQ; ld = 512; colt = (pn - 18) * 256; }
            const int col0 = colt + wc * 32 + 8 * fq;
#pragma unroll
            for (int ai = 0; ai < 2; ++ai)
#pragma unroll
                for (int m = 0; m < 4; ++m) { bf16_t* rowp = base + (size_t)(row0 + ai * HALF + m * 16) * ld + col0;
#pragma unroll
                    for (int bj = 0; bj < 2; ++bj) { f32x4 v0 = acc[ai][bj][m][0] * zs, v1 = acc[ai][bj][m][1] * zs;
                        if (act) {
#pragma unroll
                            for (int e = 0; e < 4; ++e) { v0[e] = silu_f(v0[e]) * 0.08838834764831845f; v1[e] = silu_f(v1[e]) * 0.08838834764831845f; } }
                        u32x4 w; w.x = cvt_pk_bf16(v0[0], v0[1]); w.y = cvt_pk_bf16(v0[2], v0[3]); w.z = cvt_pk_bf16(v1[0], v1[1]); w.w = cvt_pk_bf16(v1[2], v1[3]);
                        *(u32x4*)(rowp + bj * HALF) = w; } }
        } else {
            const int c8 = wc * 32 + 8 * fq;
#pragma unroll
            for (int ai = 0; ai < 2; ++ai)
#pragma unroll
                for (int m = 0; m < 4; ++m) { const int r = row0 + ai * HALF + m * 16; const f32x4 v0 = acc[ai][0][m][0] * zs, v1 = acc[ai][0][m][1] * zs;
                    if (c8 < 64) {
                        u32x4 w; w.x = cvt_pk_bf16(v0[0], v0[1]); w.y = cvt_pk_bf16(v0[2], v0[3]); w.z = cvt_pk_bf16(v1[0], v1[1]); w.w = cvt_pk_bf16(v1[2], v1[3]);
                        if (r < NTOK) { const int b = r >> 13, j = 16 + (r & (SEQ - 1)); *(u32x4*)(IKC + ((size_t)b * IKC_SUBS + (j >> 5)) * 2048 + ((c8 >> 3) * 32 + (j & 31)) * 8) = w; }
                        else if (r >= META_ROW0 && r < META_ROW0 + 16) { const int j = r - META_ROW0;
#pragma unroll
                            for (int b = 0; b < NB; ++b) *(u32x4*)(IKC + ((size_t)b * IKC_SUBS + (j >> 5)) * 2048 + ((c8 >> 3) * 32 + (j & 31)) * 8) = w; }
                    } else if (c8 == 64) {
                        if (r < NTOK) { const float sc = 0.044194173824159216f;
                            *(f32x4*)(IW + (size_t)r * 8) = v0 * sc; *(f32x4*)(IW + (size_t)r * 8 + 4) = v1 * sc; }
                    } }
        }
    }
};
struct EpiP4 {
    static constexpr bool ZEROES = false; static constexpr bool PERM = true, AFTER_DRAIN = false;
    __device__ __forceinline__ int vm_ops(const Unit& u) const { return 0; }
    __device__ __forceinline__ bool keep(const Unit&) const { return false; }
    unsigned char* ws;
    __device__ __forceinline__ void operator()(const f32x4 (&acc)[2][2][4][2], const Unit& u, int wr, int wc, int fr, int fq) const {
        if (u.pn < 8) run<true>(acc, u, wr, wc, fr, fq); else run<false>(acc, u, wr, wc, fr, fq); }
    template <bool gate>
    __device__ __forceinline__ void run(const f32x4 (&acc)[2][2][4][2], const Unit& u, int wr, int wc, int fr, int fq) const {
        const int pn = u.pn, row0 = u.pm * BM + wr * 64 + fr;
        const size_t boff = pn < 4 ? WS_RQ : pn < 8 ? WS_AQ : pn < 12 ? WS_RF : WS_RV;
        bf16_t* base = (bf16_t*)(ws + boff); unsigned char* g8 = ws + (pn < 4 ? WS_GR8 : WS_GA8);
        const int col0 = (pn & 3) * 256 + wc * 32 + 8 * fq;
        constexpr int PD = 7; u32x2 oq[PD + 1][2];
        if (gate) {
#pragma unroll
            for (int it = 0; it < PD; ++it)
#pragma unroll
                for (int bj = 0; bj < 2; ++bj) oq[it][bj] = *(const u32x2*)(g8 + (size_t)(row0 + (it >> 2) * HALF + (it & 3) * 16) * 1024 + col0 + bj * HALF); }
#pragma unroll
        for (int ai = 0; ai < 2; ++ai)
#pragma unroll
            for (int m = 0; m < 4; ++m) { const int it = ai * 4 + m; const size_t ro = (size_t)(row0 + ai * HALF + m * 16) * 1024 + col0; bf16_t* rowp = base + ro;
                if (gate && it + PD < 8) { const int ai2 = (it + PD) >> 2, m2 = (it + PD) & 3;
#pragma unroll
                    for (int bj = 0; bj < 2; ++bj) oq[(it + PD) % (PD + 1)][bj] = *(const u32x2*)(g8 + (size_t)(row0 + ai2 * HALF + m2 * 16) * 1024 + col0 + bj * HALF); }
#pragma unroll
                for (int bj = 0; bj < 2; ++bj) { f32x4 v0 = acc[ai][bj][m][0] * ZSCALE, v1 = acc[ai][bj][m][1] * ZSCALE;
                    if (gate) { const u32x2 o = oq[it % (PD + 1)][bj];
                        v0[0] = silu_f(v0[0]) * __builtin_amdgcn_cvt_f32_fp8((int)o.x, 0); v0[1] = silu_f(v0[1]) * __builtin_amdgcn_cvt_f32_fp8((int)o.x, 1); v0[2] = silu_f(v0[2]) * __builtin_amdgcn_cvt_f32_fp8((int)o.x, 2); v0[3] = silu_f(v0[3]) * __builtin_amdgcn_cvt_f32_fp8((int)o.x, 3);
                        v1[0] = silu_f(v1[0]) * __builtin_amdgcn_cvt_f32_fp8((int)o.y, 0); v1[1] = silu_f(v1[1]) * __builtin_amdgcn_cvt_f32_fp8((int)o.y, 1); v1[2] = silu_f(v1[2]) * __builtin_amdgcn_cvt_f32_fp8((int)o.y, 2); v1[3] = silu_f(v1[3]) * __builtin_amdgcn_cvt_f32_fp8((int)o.y, 3);
                        u32x2 w8; w8.x = pack4_fp8(v0[0], v0[1], v0[2], v0[3]); w8.y = pack4_fp8(v1[0], v1[1], v1[2], v1[3]);
                        *(u32x2*)(g8 + ro + bj * HALF) = w8;
                    } else {
#pragma unroll
                        for (int e = 0; e < 4; ++e) { v0[e] = fast_rcp(1.f + __builtin_amdgcn_exp2f(acc[ai][bj][m][0][e] * (-ZSCALE * LOG2E))); v1[e] = fast_rcp(1.f + __builtin_amdgcn_exp2f(acc[ai][bj][m][1][e] * (-ZSCALE * LOG2E))); }
                        u32x2 w8; w8.x = pack4_fp8(v0[0], v0[1], v0[2], v0[3]); w8.y = pack4_fp8(v1[0], v1[1], v1[2], v1[3]);
                        *(u32x2*)((unsigned char*)base + ro + bj * HALF) = w8; } }
                asm volatile("" ::: "memory"); }
    }
};
struct EpiP5 {
    static constexpr bool ZEROES = false; static constexpr bool PERM = true, AFTER_DRAIN = false;
    __device__ __forceinline__ int vm_ops(const Unit& u) const { return 16; }
    __device__ __forceinline__ bool keep(const Unit& u) const { return u.aux == 0; }
    const bf16_t *SMR, *SMA; unsigned char* MG;
    static __device__ __forceinline__ float f8(unsigned w, int k) { return k == 0 ? __builtin_amdgcn_cvt_f32_fp8((int)w, 0) : k == 1 ? __builtin_amdgcn_cvt_f32_fp8((int)w, 1) : k == 2 ? __builtin_amdgcn_cvt_f32_fp8((int)w, 2) : __builtin_amdgcn_cvt_f32_fp8((int)w, 3); }
    static __device__ __forceinline__ float g8(unsigned w, int k) { return fmaxf(f8(w, k), 1e-30f); }
    __device__ __forceinline__ void operator()(f32x4 (&acc)[2][2][4][2], const Unit& u, int wr, int wc, int fr, int fq) const {
        const int row0 = u.pm * BM + wr * 64 + fr, col0 = u.pn * BM + wc * 32 + 8 * fq; const bool second = u.aux != 0;
        const unsigned char* sma = (const unsigned char*)SMA; const unsigned char* smr = (const unsigned char*)SMR;
        if (!second) { u32x2 sa[2][4][2], sr[2][4][2];
#pragma unroll
            for (int ai = 0; ai < 2; ++ai)
#pragma unroll
                for (int m = 0; m < 4; ++m)
#pragma unroll
                    for (int bj = 0; bj < 2; ++bj) { const size_t o2 = (size_t)(row0 + ai * HALF + m * 16) * 1024 + col0 + bj * HALF;
                        sa[ai][m][bj] = *(const u32x2*)(sma + o2); sr[ai][m][bj] = *(const u32x2*)(smr + o2); }
#pragma unroll
            for (int ai = 0; ai < 2; ++ai)
#pragma unroll
                for (int m = 0; m < 4; ++m)
#pragma unroll
                    for (int bj = 0; bj < 2; ++bj) { const u32x2 a = sa[ai][m][bj], s = sr[ai][m][bj]; f32x4 v0 = acc[ai][bj][m][0], v1 = acc[ai][bj][m][1];
#pragma unroll
                        for (int e = 0; e < 4; ++e) { v0[e] *= f8(s.x, e) * fast_rcp(g8(a.x, e)); v1[e] *= f8(s.y, e) * fast_rcp(g8(a.y, e)); }
                        acc[ai][bj][m][0] = v0; acc[ai][bj][m][1] = v1; }
        } else { u32x2 sa[2][4][2];
#pragma unroll
            for (int ai = 0; ai < 2; ++ai)
#pragma unroll
                for (int m = 0; m < 4; ++m)
#pragma unroll
                    for (int bj = 0; bj < 2; ++bj) sa[ai][m][bj] = *(const u32x2*)(sma + (size_t)(row0 + ai * HALF + m * 16) * 1024 + col0 + bj * HALF);
#pragma unroll
            for (int ai = 0; ai < 2; ++ai)
#pragma unroll
                for (int m = 0; m < 4; ++m)
#pragma unroll
                    for (int bj = 0; bj < 2; ++bj) { const u32x2 a = sa[ai][m][bj]; const f32x4 v0 = acc[ai][bj][m][0], v1 = acc[ai][bj][m][1]; u32x2 w;
                        w.x = pack4_fp8(v0[0] * g8(a.x, 0) * ZSCALE, v0[1] * g8(a.x, 1) * ZSCALE, v0[2] * g8(a.x, 2) * ZSCALE, v0[3] * g8(a.x, 3) * ZSCALE);
                        w.y = pack4_fp8(v1[0] * g8(a.y, 0) * ZSCALE, v1[1] * g8(a.y, 1) * ZSCALE, v1[2] * g8(a.y, 2) * ZSCALE, v1[3] * g8(a.y, 3) * ZSCALE);
                        *(u32x2*)(MG + (size_t)(row0 + ai * HALF + m * 16) * 1024 + col0 + bj * HALF) = w; }
        }
    }
};
struct EpiP6 {
    static constexpr bool ZEROES = true; static constexpr bool PERM = true, AFTER_DRAIN = false;
    __device__ __forceinline__ int vm_ops(const Unit& u) const { return 16; }
    __device__ __forceinline__ bool keep(const Unit&) const { return false; }
    const float* X; float* OUT;
    __device__ __forceinline__ void operator()(f32x4 (&acc)[2][2][4][2], const Unit& u, int wr, int wc, int fr, int fq) const {
        const int row0 = u.pm * BM + wr * 64 + fr, col0 = u.pn * BM + wc * 32 + 8 * fq;
#pragma unroll
        for (int ai = 0; ai < 2; ++ai) { f32x4 xv[4][2][2];
#pragma unroll
            for (int m = 0; m < 4; ++m)
#pragma unroll
                for (int bj = 0; bj < 2; ++bj)
#pragma unroll
                    for (int n = 0; n < 2; ++n) xv[m][bj][n] = *(const f32x4*)(X + (size_t)(row0 + ai * HALF + m * 16) * 1024 + col0 + bj * HALF + n * 4);
#pragma unroll
            for (int m = 0; m < 4; ++m)
#pragma unroll
                for (int bj = 0; bj < 2; ++bj)
#pragma unroll
                    for (int n = 0; n < 2; ++n) { *(f32x4*)(OUT + (size_t)(row0 + ai * HALF + m * 16) * 1024 + col0 + bj * HALF + n * 4) = xv[m][bj][n] + acc[ai][bj][m][n] * ZSCALE;
                        zero_frag(acc[ai][bj][m][n]); } }
    }
};

template <class Epi, class Sched, bool ALIGN_EPI = false, bool SP2 = false, bool FP8 = false>
__device__ __forceinline__ void gemm_phase(PG8_LAS unsigned char* lds, const int K, const Sched& S, const Epi& E) {
    const int tid = threadIdx.x, wid = __builtin_amdgcn_readfirstlane(tid >> 6), lane = tid & 63, wr = wid >> 2, wc = wid & 3, fr = lane & 15, fq = lane >> 4;
    const int nt = K / BK;
    unsigned voffA[2], voffB[2];
#pragma unroll
    for (int i = 0; i < 2; ++i) { int R, C; stage_rc(tid * 16 + i * 8192, R, C); const int Rb = Epi::PERM ? ((R & ~31) + perm32(R & 31)) : R;
        voffA[i] = (unsigned)(R * K + C) * 2u; voffB[i] = (unsigned)(Rb * K + C) * 2u; }
    const size_t kstep = (size_t)(BK * 2);
    const size_t hstep = (size_t)HALF * K * 2;
    const size_t tstep = 2 * hstep;
    const unsigned ldsw = (unsigned)wid * 1024u;
    const int aoff = lds_byte(wr * 64 + fr, fq * 8), boff = lds_byte(wc * 32 + fr, fq * 8);
#define PG8_SA(b, h) (((b) * 2 + (h)) * HTB)
#define PG8_SB(b, h) ((4 + (b) * 2 + (h)) * HTB)
#define PG8_STAGE(bufoff, gbase, voff) do { _Pragma("unroll") for (int _i = 0; _i < 2; ++_i) \
        __builtin_amdgcn_global_load_lds((const unsigned*)((const char*)(gbase) + (voff)[_i]), (PG8_LAS unsigned*)(lds + (bufoff) + ldsw + _i * 8192), 16, 0, 0); } while (0)
#define PG8_LDA(dst, b, h) do { _Pragma("unroll") for (int m = 0; m < 4; ++m) _Pragma("unroll") for (int k = 0; k < 2; ++k) dst[m][k] = *(const PG8_LAS bf16x8*)(lds + PG8_SA(b, h) + aoff + m * 2048 + k * 1024); } while (0)
#define PG8_LDB(dst, b, h) do { _Pragma("unroll") for (int n = 0; n < 2; ++n) _Pragma("unroll") for (int k = 0; k < 2; ++k) dst[n][k] = *(const PG8_LAS bf16x8*)(lds + PG8_SB(b, h) + boff + n * 2048 + k * 1024); } while (0)
#define PG8_MMA(ai, bj, At, Bt) do { __builtin_amdgcn_s_setprio(1); _Pragma("unroll") for (int m = 0; m < 4; ++m) _Pragma("unroll") for (int n = 0; n < 2; ++n) { \
        if constexpr (FP8) { pg8_mfma8(acc[ai][bj][m][n], pg8_cat(Bt[n][0], Bt[n][1]), pg8_cat(At[m][0], At[m][1]), one8); } \
        else { _Pragma("unroll") for (int k = 0; k < 2; ++k) acc[ai][bj][m][n] = __builtin_amdgcn_mfma_f32_16x16x32_bf16(Bt[n][k], At[m][k], acc[ai][bj][m][n], 0, 0, 0); } } __builtin_amdgcn_s_setprio(0); } while (0)
#define PG8_WAIT_V(n) asm volatile("s_waitcnt vmcnt(" #n ")" ::: "memory")
#define PG8_WAIT_L(n) asm volatile("s_waitcnt lgkmcnt(" #n ")" ::: "memory")
#define PG8_BAR __builtin_amdgcn_s_barrier()
#define PG8_SCHED __builtin_amdgcn_sched_barrier(0)
    Unit cur, nxt; int ui = 0; int prev_ops = 0;
    if (!S.next(0, cur)) return;
    f32x4 acc[2][2][4][2];
    const int one8 = 0x7f7f7f7f;
#pragma unroll
    for (int a = 0; a < 2; ++a)
#pragma unroll
        for (int b = 0; b < 2; ++b)
#pragma unroll
            for (int m = 0; m < 4; ++m)
#pragma unroll
                for (int n = 0; n < 2; ++n) acc[a][b][m][n] = (f32x4){0.f, 0.f, 0.f, 0.f};
    bf16x8 At[4][2], B0[2][2], B1[2][2];
    const char* cA = (const char*)cur.A + (size_t)cur.pm * tstep; const char* cB = (const char*)cur.Bt + (size_t)cur.pn * tstep;
    S.a_ready(cur);
    if constexpr (SP2) {
        PG8_STAGE(PG8_SB(0, 0), cB, voffB); PG8_STAGE(PG8_SB(0, 1), cB + hstep, voffB); PG8_STAGE(PG8_SA(0, 0), cA, voffA); PG8_STAGE(PG8_SA(0, 1), cA + hstep, voffA);
        if (wr == 1) PG8_BAR;
        PG8_WAIT_V(2); PG8_BAR;
        PG8_STAGE(PG8_SB(1, 0), cB + kstep, voffB); PG8_STAGE(PG8_SA(1, 0), cA + kstep, voffA); PG8_STAGE(PG8_SB(1, 1), cB + hstep + kstep, voffB);
        PG8_WAIT_V(6); PG8_BAR;
    } else {
        PG8_STAGE(PG8_SB(0, 0), cB, voffB); PG8_STAGE(PG8_SA(0, 0), cA, voffA); PG8_STAGE(PG8_SB(0, 1), cB + hstep, voffB); PG8_STAGE(PG8_SA(0, 1), cA + hstep, voffA);
        if (wr == 1) PG8_BAR;
        PG8_WAIT_V(4); PG8_BAR;
        PG8_STAGE(PG8_SB(1, 0), cB + kstep, voffB); PG8_STAGE(PG8_SA(1, 0), cA + kstep, voffA); PG8_STAGE(PG8_SB(1, 1), cB + hstep + kstep, voffB);
        PG8_WAIT_V(6); PG8_BAR;
    }
    for (;;) {
        const bool has_next = S.next(ui + 1, nxt);
        const char* nA = has_next ? (const char*)nxt.A + (size_t)nxt.pm * tstep : cA; const char* nB = has_next ? (const char*)nxt.Bt + (size_t)nxt.pn * tstep : cB;
#pragma unroll 1
        for (int t = 0; t < nt; t += 2) {
            const bool last = (t == nt - 2);
            const bool relax = (t == 0) && (prev_ops >= 16);
            const char* a1 = cA + (size_t)(t + 1) * kstep;
            const char* a2 = last ? nA : cA + (size_t)(t + 2) * kstep; const char* b2 = last ? nB : cB + (size_t)(t + 2) * kstep;
            const char* a3 = a2 + kstep; const char* b3 = b2 + kstep;
            if (last && has_next) S.a_ready(nxt);
            if constexpr (SP2) {
            PG8_LDB(B0, 0, 0); PG8_LDB(B1, 0, 1); PG8_SCHED; PG8_LDA(At, 0, 0); PG8_STAGE(PG8_SA(1, 1), a1 + hstep, voffA);
            if (relax) PG8_WAIT_V(24); else PG8_WAIT_V(8); PG8_WAIT_L(0); PG8_BAR; PG8_MMA(0, 0, At, B0); PG8_MMA(0, 1, At, B1); PG8_BAR; PG8_SCHED;
            PG8_LDA(At, 0, 1); PG8_STAGE(PG8_SB(0, 0), b2, voffB); PG8_STAGE(PG8_SB(0, 1), b2 + hstep, voffB); PG8_STAGE(PG8_SA(0, 0), a2, voffA);
            if (relax) PG8_WAIT_V(24); else PG8_WAIT_V(8); PG8_WAIT_L(0); PG8_BAR; PG8_MMA(1, 0, At, B0); PG8_MMA(1, 1, At, B1); PG8_BAR; PG8_SCHED;
            PG8_LDB(B0, 1, 0); PG8_LDB(B1, 1, 1); PG8_SCHED; PG8_LDA(At, 1, 0); PG8_STAGE(PG8_SA(0, 1), a2 + hstep, voffA);
            PG8_WAIT_V(8); PG8_WAIT_L(0); PG8_BAR; PG8_MMA(0, 0, At, B0); PG8_MMA(0, 1, At, B1); PG8_BAR; PG8_SCHED;
            PG8_LDA(At, 1, 1); PG8_STAGE(PG8_SB(1, 0), b3, voffB); PG8_STAGE(PG8_SB(1, 1), b3 + hstep, voffB); PG8_STAGE(PG8_SA(1, 0), a3, voffA);
            PG8_WAIT_V(8); PG8_WAIT_L(0); PG8_BAR; PG8_MMA(1, 0, At, B0); PG8_MMA(1, 1, At, B1); PG8_BAR; PG8_SCHED;
            } else {
            PG8_LDB(B0, 0, 0); PG8_SCHED; PG8_LDA(At, 0, 0); PG8_STAGE(PG8_SA(1, 1), a1 + hstep, voffA);
            PG8_WAIT_L(8); PG8_BAR; PG8_WAIT_L(0); PG8_MMA(0, 0, At, B0); PG8_BAR; PG8_SCHED;
            PG8_LDB(B1, 0, 1); PG8_STAGE(PG8_SB(0, 0), b2, voffB);
            PG8_BAR; PG8_WAIT_L(0); PG8_MMA(0, 1, At, B1); PG8_BAR;
            PG8_LDA(At, 0, 1); PG8_STAGE(PG8_SA(0, 0), a2, voffA);
            PG8_BAR; PG8_WAIT_L(0); PG8_MMA(1, 0, At, B0); PG8_BAR; PG8_SCHED;
            PG8_STAGE(PG8_SB(0, 1), b2 + hstep, voffB);
            PG8_WAIT_V(6); PG8_BAR; PG8_MMA(1, 1, At, B1); PG8_BAR;
            PG8_LDB(B0, 1, 0); PG8_SCHED; PG8_LDA(At, 1, 0); PG8_STAGE(PG8_SA(0, 1), a2 + hstep, voffA);
            PG8_WAIT_L(8); PG8_BAR; PG8_WAIT_L(0); PG8_MMA(0, 0, At, B0); PG8_BAR; PG8_SCHED;
            PG8_LDB(B1, 1, 1); PG8_STAGE(PG8_SB(1, 0), b3, voffB);
            PG8_BAR; PG8_WAIT_L(0); PG8_MMA(0, 1, At, B1); PG8_BAR;
            PG8_LDA(At, 1, 1); PG8_STAGE(PG8_SA(1, 0), a3, voffA);
            PG8_BAR; PG8_WAIT_L(0); PG8_MMA(1, 0, At, B0); PG8_BAR; PG8_SCHED;
            PG8_STAGE(PG8_SB(1, 1), b3 + hstep, voffB);
            PG8_WAIT_V(6); PG8_BAR; PG8_MMA(1, 1, At, B1); PG8_BAR;
            }
        }
        if constexpr (ALIGN_EPI) { if (wr == 0) PG8_BAR; }
        if constexpr (ALIGN_EPI) { if (ui == 0) ::grid_wait_hook(S.pend, (unsigned)(uintptr_t)lds); }
        if constexpr (FP8) {
#pragma unroll
            for (int a_ = 0; a_ < 2; ++a_) asm volatile("s_nop 15\n\ts_nop 15" : "+v"(acc[a_][0][0][0]), "+v"(acc[a_][0][0][1]), "+v"(acc[a_][0][1][0]), "+v"(acc[a_][0][1][1]), "+v"(acc[a_][0][2][0]), "+v"(acc[a_][0][2][1]), "+v"(acc[a_][0][3][0]), "+v"(acc[a_][0][3][1]),
                                                                        "+v"(acc[a_][1][0][0]), "+v"(acc[a_][1][0][1]), "+v"(acc[a_][1][1][0]), "+v"(acc[a_][1][1][1]), "+v"(acc[a_][1][2][0]), "+v"(acc[a_][1][2][1]), "+v"(acc[a_][1][3][0]), "+v"(acc[a_][1][3][1]));
        }
        if constexpr (!Epi::AFTER_DRAIN) { E(acc, cur, wr, wc, fr, fq); S.done(cur); prev_ops = E.vm_ops(cur); }
        if (!has_next) break;
        if (!Epi::ZEROES && !E.keep(cur)) {
#pragma unroll
        for (int a = 0; a < 2; ++a)
#pragma unroll
            for (int b = 0; b < 2; ++b)
#pragma unroll
                for (int m = 0; m < 4; ++m)
#pragma unroll
                    for (int n = 0; n < 2; ++n) acc[a][b][m][n] = (f32x4){0.f, 0.f, 0.f, 0.f};
        }
        cur = nxt; cA = nA; cB = nB; ++ui;
        if constexpr (ALIGN_EPI) { if (wr == 1) PG8_BAR; }
    }
    PG8_WAIT_V(0);
    if constexpr (!ALIGN_EPI) { if (wr == 0) PG8_BAR; }
    PG8_BAR;
    if constexpr (Epi::AFTER_DRAIN) { E.fused(acc, cur, wr, wc, fr, fq, lds, wid, lane); S.done(cur); }
#undef PG8_SA
#undef PG8_SB
#undef PG8_STAGE
#undef PG8_LDA
#undef PG8_LDB
#undef PG8_MMA
#undef PG8_WAIT_V
#undef PG8_WAIT_L
#undef PG8_BAR
#undef PG8_SCHED
}
}

constexpr int RING_BYTES = 131072;
constexpr int LDSCTL_OFF = 143360, MISC_OFF = LDSCTL_OFF + 320;
constexpr int LDS_BYTES = 147456;
constexpr int NWAVES = 8;

#define LDS_WAIT() asm volatile("s_waitcnt lgkmcnt(0)" ::: "memory")
#define VM_WAIT() asm volatile("s_waitcnt vmcnt(0)" ::: "memory")

#define XB_TMO      128
#define XB_XCNT(j)  (256  + 64 * (j))
#define XB_XSUB(j)  (1280 + 64 * (j))
#define XB_XGEN(j)  (2304 + 64 * (j))
#define XB_TOP      3328
#define XB_TOPGEN   3392
#define XCD_BAR_WORDS 3456
#define XB_SPIN_CAP (1u << 18)

__device__ __forceinline__ unsigned xb_ld(unsigned* p)              { return __hip_atomic_load(p, __ATOMIC_RELAXED, __HIP_MEMORY_SCOPE_AGENT); }
__device__ __forceinline__ unsigned xb_add(unsigned* p, unsigned v) { return __hip_atomic_fetch_add(p, v, __ATOMIC_RELAXED, __HIP_MEMORY_SCOPE_AGENT); }
__device__ __forceinline__ unsigned xb_xcc_id() { return (unsigned)__builtin_amdgcn_s_getreg((3 << 11) | 20) & 0xFu; }
#define XB_SPIN(cond, bar) do { unsigned _sp = 0; while (cond) { __builtin_amdgcn_s_sleep(1); \
    if ((++_sp & 255u) == 0u) { if (xb_ld(&(bar)[XB_TMO])) break; if (_sp > XB_SPIN_CAP) { atomicAdd(&(bar)[XB_TMO], 1u); break; } } } } while (0)

struct XcdBarrier {
    unsigned* bar; unsigned x;
    volatile LAS unsigned* st;
};

__device__ __forceinline__ XcdBarrier xcd_barrier_post(unsigned* bar, volatile LAS unsigned* st) {
    XcdBarrier b; b.bar = bar; b.x = xb_xcc_id(); b.st = st;
    if (threadIdx.x == 0) (void)xb_add(&bar[XB_XCNT(b.x)], 1u);
    return b;
}
__device__ __forceinline__ void xcd_barrier_complete(unsigned* bar, unsigned x, unsigned& nloc, unsigned& nx) {
    const unsigned G = gridDim.x * gridDim.y * gridDim.z;
    unsigned sum, cnt, mine, sp = 0u;
    for (;;) {
        sum = 0u; cnt = 0u; mine = 0u;
#pragma unroll
        for (unsigned j = 0; j < 16; ++j) { const unsigned c = xb_ld(&bar[XB_XCNT(j)]); sum += c; cnt += (c > 0u) ? 1u : 0u; mine = (j == x) ? c : mine; }
        if (sum == G) break;
        __builtin_amdgcn_s_sleep(1);
        if ((++sp & 255u) == 0u) { if (xb_ld(&bar[XB_TMO])) break; if (sp > XB_SPIN_CAP) { atomicAdd(&bar[XB_TMO], 1u); break; } }
    }
    nloc = mine > 0u ? mine : 1u; nx = cnt > 0u ? cnt : 1u;
}

__device__ __forceinline__ void xcd_barrier(const XcdBarrier& b) {
    asm volatile("s_waitcnt vmcnt(0)" ::: "memory");
    __syncthreads();
    if (threadIdx.x == 0) {
        unsigned* bar = b.bar;
        __builtin_amdgcn_s_waitcnt(0);
        unsigned nloc = b.st[0], nx = b.st[1];
        if (nloc == 0u) { xcd_barrier_complete(bar, b.x, nloc, nx); b.st[0] = nloc; b.st[1] = nx; }
        const unsigned old = xb_add(&bar[XB_XSUB(b.x)], 1u);
        const unsigned gen = old / nloc;
        if (old + 1u == (gen + 1u) * nloc) {
            __builtin_amdgcn_fence(__ATOMIC_RELEASE, "agent");
            asm volatile("s_waitcnt vmcnt(0)" ::: "memory");
            const unsigned og = xb_add(&bar[XB_TOP], 1u);
            const unsigned tg = og / nx;
            if (og + 1u == (tg + 1u) * nx) xb_add(&bar[XB_TOPGEN], 1u);
            else XB_SPIN(xb_ld(&bar[XB_TOPGEN]) == tg, bar);
            __builtin_amdgcn_fence(__ATOMIC_ACQUIRE, "agent");
            xb_add(&bar[XB_XGEN(b.x)], 1u);
            asm volatile("s_waitcnt vmcnt(0)" ::: "memory");
        } else {
            XB_SPIN(xb_ld(&bar[XB_XGEN(b.x)]) == gen, bar);
            __builtin_amdgcn_fence(__ATOMIC_ACQUIRE, "agent");
            asm volatile("s_waitcnt vmcnt(0)" ::: "memory");
        }
    }
    __syncthreads();
}

__device__ __forceinline__ void xcd_barrier_arrive(const XcdBarrier& b) {
    asm volatile("s_waitcnt vmcnt(0)" ::: "memory");
    __syncthreads();
    if (threadIdx.x == 0) {
        unsigned* bar = b.bar;
        __builtin_amdgcn_s_waitcnt(0);
        unsigned nloc = b.st[0], nx = b.st[1];
        if (nloc == 0u) { xcd_barrier_complete(bar, b.x, nloc, nx); b.st[0] = nloc; b.st[1] = nx; }
        const unsigned old = xb_add(&bar[XB_XSUB(b.x)], 1u);
        const unsigned gen = old / nloc;
        unsigned leader = 0u, tg = 0u;
        if (old + 1u == (gen + 1u) * nloc) {
            leader = 1u;
            __builtin_amdgcn_fence(__ATOMIC_RELEASE, "agent");
            asm volatile("s_waitcnt vmcnt(0)" ::: "memory");
            const unsigned og = xb_add(&bar[XB_TOP], 1u);
            tg = og / nx;
            if (og + 1u == (tg + 1u) * nx) xb_add(&bar[XB_TOPGEN], 1u);
        }
        b.st[2] = leader; b.st[3] = gen; b.st[4] = tg;
    }
}
__device__ __forceinline__ void xcd_barrier_wait(const XcdBarrier& b) {
    if (threadIdx.x == 0) {
        unsigned* bar = b.bar;
        const unsigned leader = b.st[2], gen = b.st[3], tg = b.st[4];
        if (leader) {
            XB_SPIN(xb_ld(&bar[XB_TOPGEN]) == tg, bar);
            __builtin_amdgcn_fence(__ATOMIC_ACQUIRE, "agent");
            xb_add(&bar[XB_XGEN(b.x)], 1u);
            asm volatile("s_waitcnt vmcnt(0)" ::: "memory");
        } else {
            XB_SPIN(xb_ld(&bar[XB_XGEN(b.x)]) == gen, bar);
            __builtin_amdgcn_fence(__ATOMIC_ACQUIRE, "agent");
            asm volatile("s_waitcnt vmcnt(0)" ::: "memory");
        }
    }
    __syncthreads();
}

__device__ __forceinline__ void grid_wait_hook(unsigned* pbar, unsigned lds_addr) {
    if (pbar) { XcdBarrier b; b.bar = pbar; b.x = xb_xcc_id(); b.st = (volatile LAS unsigned*)(uintptr_t)(lds_addr + MISC_OFF) + 8; xcd_barrier_wait(b); } }

struct Frame {
    LAS unsigned char* lds;
    int tid, lane, wave, vcu, G;
};

__device__ __forceinline__ int src_col_1a(int n) {
    if (n < 3072) return n;
    if (n < 4096) return C_AQ + (n - 3072);
    if (n < 4608) return C_AK + (n - 4096);
    if (n < 5120) return C_IQ + (n - 4608);
    if (n < 5192) return C_IK + (n - 5120);
    return -1;
}
__device__ __forceinline__ int src_col_1b(int n) {
    if (n < 1024) return C_RG + n;
    if (n < 2048) return C_AG + (n - 1024);
    return C_MR + (n - 2048);
}
template <bool FP8>
__device__ __forceinline__ void p0_transpose_item(const float* W, int ldw, int mode, int n_base, void* WT, int nblk, LAS float* scr, int item, int lane) {
    const int kb = item / nblk, nb = item % nblk, k0 = 64 * kb, n0 = 32 * nb;
    const int n = n_base + n0 + (lane & 31); const int sc = mode == 0 ? n : mode == 1 ? src_col_1a(n) : src_col_1b(n);
    { float wv_[32];
#pragma unroll
      for (int i = 0; i < 32; ++i) { const int kk = 2 * i + (lane >> 5); wv_[i] = sc >= 0 ? W[(size_t)(k0 + kk) * ldw + sc] : 0.f; }
#pragma unroll
      for (int i = 0; i < 32; ++i) { const int kk = 2 * i + (lane >> 5); scr[kk * 33 + (lane & 31)] = wv_[i]; } }
    LDS_WAIT(); asm volatile("" ::: "memory");
    const int c = lane & 7;
#pragma unroll
    for (int j = 0; j < 4; ++j) { const int nn = (lane >> 3) + 8 * j; const LAS float* s = scr + (8 * c) * 33 + nn;
        if (FP8) { u32x2 o; o.x = pack4_fp8(s[0 * 33] * WSCALE, s[1 * 33] * WSCALE, s[2 * 33] * WSCALE, s[3 * 33] * WSCALE); o.y = pack4_fp8(s[4 * 33] * WSCALE, s[5 * 33] * WSCALE, s[6 * 33] * WSCALE, s[7 * 33] * WSCALE);
            *(u32x2*)((unsigned char*)WT + (size_t)(n0 + nn) * 1024 + k0 + 8 * c) = o; }
        else { u32x4 o; o.x = cvt_pk_bf16(s[0 * 33], s[1 * 33]); o.y = cvt_pk_bf16(s[2 * 33], s[3 * 33]); o.z = cvt_pk_bf16(s[4 * 33], s[5 * 33]); o.w = cvt_pk_bf16(s[6 * 33], s[7 * 33]);
            *(u32x4*)((bf16_t*)WT + (size_t)(n0 + nn) * 1024 + k0 + 8 * c) = o; } }
    LDS_WAIT(); asm volatile("" ::: "memory");
}
__device__ __forceinline__ void rms_row_to_bf16(const float* xrow, const float* g, bf16_t* orow, unsigned char* orow8, int lane) {
    const f32x4* xr = (const f32x4*)xrow + lane; const f32x4* gr = (const f32x4*)g + lane;
    f32x4 v[4]; float s = 0.f;
#pragma unroll
    for (int j = 0; j < 4; ++j) { v[j] = xr[64 * j]; s += (v[j].x * v[j].x + v[j].y * v[j].y) + (v[j].z * v[j].z + v[j].w * v[j].w); }
    const float rstd = __builtin_amdgcn_rsqf(wave_sum(s) * (1.f / 1024.f) + EPS);
    u32x2* o8 = (u32x2*)orow + lane; unsigned* o4 = (unsigned*)orow8 + lane;
#pragma unroll
    for (int j = 0; j < 4; ++j) { const f32x4 gg = gr[64 * j]; const float a = v[j].x * rstd * gg.x, b = v[j].y * rstd * gg.y, c = v[j].z * rstd * gg.z, d = v[j].w * rstd * gg.w;
        u32x2 w; w.x = cvt_pk_bf16(a, b); w.y = cvt_pk_bf16(c, d); o8[64 * j] = w; o4[64 * j] = pack4_fp8(a, b, c, d); }
}
struct P0Args { const float *x, *meta, *norm_g, *w_in, *lb_logits, *w_r, *w_a, *w_out; unsigned char *W1A8, *W1B8, *WR8, *WA8, *WO8, *XN8; bf16_t *W1AI, *XN; float* LB; };
__device__ __forceinline__ void p0_prologue(const Frame& F, const P0Args& a) {
    LAS float* scr = (LAS float*)(F.lds + F.wave * 16384);
    const int gw = F.vcu * NWAVES + F.wave, NGW = F.G * NWAVES;
    constexpr int I_A = 16 * (N1A8 / 32), I_I = 16 * (N1AI / 32), I_B = 16 * (N1B / 32), I_S = 16 * 32;
    constexpr int NITEMS = I_A + I_I + I_B + 3 * I_S;
    for (int it = gw; it < NITEMS; it += NGW) {
        int r = it;
        if (r < I_A) { p0_transpose_item<true>(a.w_in, D_IN, 1, 0, a.W1A8, N1A8 / 32, scr, r, F.lane); continue; } r -= I_A;
        if (r < I_I) { p0_transpose_item<false>(a.w_in, D_IN, 1, N1A8, a.W1AI, N1AI / 32, scr, r, F.lane); continue; } r -= I_I;
        if (r < I_B) { p0_transpose_item<true>(a.w_in, D_IN, 2, 0, a.W1B8, N1B / 32, scr, r, F.lane); continue; } r -= I_B;
        if (r < I_S) { p0_transpose_item<true>(a.w_r, 1024, 0, 0, a.WR8, 32, scr, r, F.lane); continue; } r -= I_S;
        if (r < I_S) { p0_transpose_item<true>(a.w_a, 1024, 0, 0, a.WA8, 32, scr, r, F.lane); continue; } r -= I_S;
        p0_transpose_item<true>(a.w_out, 1024, 0, 0, a.WO8, 32, scr, r, F.lane);
    }
    { constexpr int RPP = 8; f32x4 gg[4];
#pragma unroll
      for (int j = 0; j < 4; ++j) gg[j] = ((const f32x4*)a.norm_g)[F.lane + 64 * j];
      for (int m0 = gw; m0 < NTOK; m0 += RPP * NGW) {
        f32x4 v[RPP][4]; float s[RPP];
#pragma unroll
        for (int q = 0; q < RPP; ++q) { const int m = m0 + q * NGW; const f32x4* xr = (const f32x4*)(a.x + (size_t)(m < NTOK ? m : m0) * DM) + F.lane;
#pragma unroll
            for (int j = 0; j < 4; ++j) v[q][j] = xr[64 * j]; }
#pragma unroll
        for (int q = 0; q < RPP; ++q) { float t = 0.f;
#pragma unroll
            for (int j = 0; j < 4; ++j) t += (v[q][j].x * v[q][j].x + v[q][j].y * v[q][j].y) + (v[q][j].z * v[q][j].z + v[q][j].w * v[q][j].w);
            s[q] = t; }
#pragma unroll
        for (int o = 1; o < 64; o <<= 1) {
#pragma unroll
            for (int q = 0; q < RPP; ++q) s[q] += __shfl_xor(s[q], o); }
#pragma unroll
        for (int q = 0; q < RPP; ++q) { const int m = m0 + q * NGW; if (m >= NTOK) continue;
            const float rstd = __builtin_amdgcn_rsqf(s[q] * (1.f / 1024.f) + EPS);
            u32x2* o8 = (u32x2*)(a.XN + (size_t)m * DM) + F.lane; unsigned* o4 = (unsigned*)(a.XN8 + (size_t)m * DM) + F.lane;
#pragma unroll
            for (int j = 0; j < 4; ++j) { const float c0 = v[q][j].x * rstd * gg[j].x, c1 = v[q][j].y * rstd * gg[j].y, c2 = v[q][j].z * rstd * gg[j].z, c3 = v[q][j].w * rstd * gg[j].w;
                u32x2 w; w.x = cvt_pk_bf16(c0, c1); w.y = cvt_pk_bf16(c2, c3); o8[64 * j] = w; o4[64 * j] = pack4_fp8(c0, c1, c2, c3); } } } }
    for (int m = NTOK + gw; m < MROWS; m += NGW) {
        if (m < NTOK) rms_row_to_bf16(a.x + (size_t)m * DM, a.norm_g, a.XN + (size_t)m * DM, a.XN8 + (size_t)m * DM, F.lane);
        else if (m >= META_ROW0 && m < META_ROW0 + 16) rms_row_to_bf16(a.meta + (size_t)(m - META_ROW0) * DM, a.norm_g, a.XN + (size_t)m * DM, a.XN8 + (size_t)m * DM, F.lane);
        else { u32x2* o8 = (u32x2*)(a.XN + (size_t)m * DM) + F.lane; unsigned* o4 = (unsigned*)(a.XN8 + (size_t)m * DM) + F.lane; const u32x2 z = {0u, 0u};
#pragma unroll
            for (int j = 0; j < 4; ++j) { o8[64 * j] = z; o4[64 * j] = 0u; } }
    }
    if (blockIdx.x == 0) {
        for (int k = F.tid; k < 1024; k += NWAVES * 64) { const float l0 = a.lb_logits[k], l1 = a.lb_logits[1024 + k]; a.LB[k] = 1.f / (1.f + __expf(l1 - l0)); }
    }
}

constexpr int HG_QT = 0, HG_KT = 17408, HG_KHT = 34816, HG_VT = 53248, HG_PL = 71680, HG_SW = 80896, HG_OT = 115712, HG_PART = 133120, HG_DV = 137216, HG_P2 = 137728, HG_END = 139776;
static_assert(HG_END <= LDSCTL_OFF, "HGRN LDS map");
struct HgArgs { const bf16_t *RQ, *RF, *RV; bf16_t* OR_; const float *LB, *RNG; float *SLOC, *DSEG; };

template <int CTRL> __device__ __forceinline__ float dpp_f_(float v) { return __builtin_bit_cast(float, __builtin_amdgcn_update_dpp(0, __builtin_bit_cast(int, v), CTRL, 0xf, 0xf, true)); }
#define dpp_f(v, ctrl) dpp_f_<ctrl>(v)
__device__ __forceinline__ f32x4 mfma16(bf16x8 a, bf16x8 b, f32x4 c) { return __builtin_amdgcn_mfma_f32_16x16x32_bf16(a, b, c, 0, 0, 0); }
__device__ __forceinline__ bf16x8 lds_b128(LAS unsigned char* p) { return *(LAS bf16x8*)p; }

struct HgRegs { unsigned F2[8], V2[8], Q2[8]; };
template <bool FULL>
__device__ __forceinline__ void hg_load(HgRegs& R, const HgArgs& A, size_t row0, int h, int lane, int w) {
    const size_t cb = row0 * 1024 + (size_t)h * 128 + 2 * lane;
#pragma unroll
    for (int i = 0; i < 8; ++i) { const size_t o = cb + (size_t)(8 * w + i) * 1024; R.F2[i] = *(const unsigned*)(A.RF + o); { const unsigned v8_ = *(const unsigned short*)((const unsigned char*)A.RV + o); R.V2[i] = cvt_pk_bf16(__builtin_amdgcn_cvt_f32_fp8((int)v8_, 0), __builtin_amdgcn_cvt_f32_fp8((int)v8_, 1)); }     if (FULL) R.Q2[i] = *(const unsigned short*)((const unsigned char*)A.RQ + o); }
}
template <bool FULL>
__device__ __forceinline__ void hg_chunk(LAS unsigned char* lds, const HgArgs& A, const HgRegs& R, size_t row0, int h, int validFrom, f32x4 (&Sacc)[8], float& logD0, float& logD1, int tid, int lane, int w, float lb0, float lb1, float gn) {
    const int r = lane & 15, g = lane >> 4;
    {
        const unsigned (&F2)[8] = R.F2; const unsigned (&V2)[8] = R.V2; const unsigned (&Q2)[8] = R.Q2;
        float c0[8], c1[8], k0[8], k1[8]; float run0 = 1.f, run1 = 1.f;
#pragma unroll
        for (int i = 0; i < 8; ++i) { const bool valid = (8 * w + i) >= validFrom;
            const float f0 = lb0 + (1.f - lb0) * sigmoid_f(bflo(F2[i])), f1 = lb1 + (1.f - lb1) * sigmoid_f(bfhi(F2[i]));
            k0[i] = valid ? 1.f - f0 : 0.f; k1[i] = valid ? 1.f - f1 : 0.f;
            run0 *= valid ? f0 : 1.f; run1 *= valid ? f1 : 1.f; c0[i] = run0; c1[i] = run1; }
        *(LAS f32x2*)(lds + HG_PART + (w * 128 + 2 * lane) * 4) = (f32x2){run0, run1};
        LDS_WAIT(); __syncthreads();
        float off0 = 1.f, off1 = 1.f, tot0 = 1.f, tot1 = 1.f;
#pragma unroll
        for (int ww = 0; ww < 8; ++ww) { const f32x2 p = *(LAS f32x2*)(lds + HG_PART + (ww * 128 + 2 * lane) * 4); if (ww < w) { off0 *= p.x; off1 *= p.y; } tot0 *= p.x; tot1 *= p.y; }
        logD0 *= tot0; logD1 *= tot1;
        const float ebl0 = tot0, ebl1 = tot1;
        float kh0[8], kh1[8];
#pragma unroll
        for (int i = 0; i < 8; ++i) { const float e0 = off0 * c0[i], e1 = off1 * c1[i];
            const float kt0 = k0[i] * fast_rcp(e0), kt1 = k1[i] * fast_rcp(e1);
            kh0[i] = kt0 * ebl0; kh1[i] = kt1 * ebl1;
            if (FULL) { const int t = 8 * w + i;
                *(LAS unsigned*)(lds + HG_QT + t * 272 + 4 * lane) = cvt_pk_bf16(__builtin_amdgcn_cvt_f32_fp8((int)Q2[i], 0) * e0, __builtin_amdgcn_cvt_f32_fp8((int)Q2[i], 1) * e1);
                *(LAS unsigned*)(lds + HG_KT + t * 272 + 4 * lane) = cvt_pk_bf16(kt0, kt1); } }
        { u32x4 a, b; a.x = cvt_pk_bf16(kh0[0], kh0[1]); a.y = cvt_pk_bf16(kh0[2], kh0[3]); a.z = cvt_pk_bf16(kh0[4], kh0[5]); a.w = cvt_pk_bf16(kh0[6], kh0[7]);
          b.x = cvt_pk_bf16(kh1[0], kh1[1]); b.y = cvt_pk_bf16(kh1[2], kh1[3]); b.z = cvt_pk_bf16(kh1[4], kh1[5]); b.w = cvt_pk_bf16(kh1[6], kh1[7]);
          *(LAS u32x4*)(lds + HG_KHT + (2 * lane) * 144 + 16 * w) = a; *(LAS u32x4*)(lds + HG_KHT + (2 * lane + 1) * 144 + 16 * w) = b; }
        { u32x4 a, b;
          a.x = (V2[0] & 0xffffu) | (V2[1] << 16); a.y = (V2[2] & 0xffffu) | (V2[3] << 16); a.z = (V2[4] & 0xffffu) | (V2[5] << 16); a.w = (V2[6] & 0xffffu) | (V2[7] << 16);
          b.x = (V2[0] >> 16) | (V2[1] & 0xffff0000u); b.y = (V2[2] >> 16) | (V2[3] & 0xffff0000u); b.z = (V2[4] >> 16) | (V2[5] & 0xffff0000u); b.w = (V2[6] >> 16) | (V2[7] & 0xffff0000u);
          *(LAS u32x4*)(lds + HG_VT + (2 * lane) * 144 + 16 * w) = a; *(LAS u32x4*)(lds + HG_VT + (2 * lane + 1) * 144 + 16 * w) = b; }
        if (w == 0) *(LAS f32x2*)(lds + HG_DV + 8 * lane) = (f32x2){ebl0, ebl1};
    }
    f32x4 oacc[4];
    if (FULL) {
#pragma unroll
        for (int i = 0; i < 8; ++i) { u32x2 pk; pk.x = cvt_pk_bf16(Sacc[i][0], Sacc[i][1]); pk.y = cvt_pk_bf16(Sacc[i][2], Sacc[i][3]);
            *(LAS u32x2*)(lds + HG_SW + w * 4352 + r * 272 + (16 * i + 4 * g) * 2) = pk; }
    }
    LDS_WAIT(); __syncthreads();
    if (FULL) {
#pragma unroll
        for (int rep = 0; rep < 2; ++rep) {
            const int id = rep == 0 ? w : 8 + w;
            if (rep == 1 && w >= 2) break;
            int tt, st;
            if (id == 0) { tt = 0; st = 0; } else if (id < 3) { tt = 1; st = id - 1; } else if (id < 6) { tt = 2; st = id - 3; } else { tt = 3; st = id - 6; }
            f32x4 acc = {0.f, 0.f, 0.f, 0.f};
#pragma unroll
            for (int ks = 0; ks < 4; ++ks) { const bf16x8 a = lds_b128(lds + HG_KT + (16 * st + r) * 272 + (32 * ks + 8 * g) * 2), b = lds_b128(lds + HG_QT + (16 * tt + r) * 272 + (32 * ks + 8 * g) * 2); acc = mfma16(a, b, acc); }
            asm volatile("s_nop 15" : "+v"(acc));
            if (st == tt) {
#pragma unroll
                for (int e = 0; e < 4; ++e) if (4 * g + e > r) acc[e] = 0.f; }
            u32x2 pk; pk.x = cvt_pk_bf16(acc[0], acc[1]); pk.y = cvt_pk_bf16(acc[2], acc[3]);
            *(LAS u32x2*)(lds + HG_PL + (16 * tt + r) * 144 + (16 * st + 4 * g) * 2) = pk;
        }
        LDS_WAIT(); __syncthreads();
#pragma unroll
        for (int tt = 0; tt < 4; ++tt) { f32x4 o = {0.f, 0.f, 0.f, 0.f};
#pragma unroll
            for (int ks = 0; ks < 4; ++ks) { const bf16x8 a = lds_b128(lds + HG_QT + (16 * tt + r) * 272 + (32 * ks + 8 * g) * 2), b = lds_b128(lds + HG_SW + w * 4352 + r * 272 + (32 * ks + 8 * g) * 2); o = mfma16(a, b, o); }
#pragma unroll
            for (int ks = 0; ks < 2; ++ks) { if (ks == 1 && tt < 2) break;
                const bf16x8 a = lds_b128(lds + HG_PL + (16 * tt + r) * 144 + (32 * ks + 8 * g) * 2), b = lds_b128(lds + HG_VT + (16 * w + r) * 144 + (32 * ks + 8 * g) * 2); o = mfma16(a, b, o); }
            oacc[tt] = o; }
    }
#pragma unroll
    for (int i = 0; i < 8; ++i) { const f32x4 dd = *(LAS f32x4*)(lds + HG_DV + (16 * i + 4 * g) * 4); f32x4 s = Sacc[i] * dd;
#pragma unroll
        for (int ks = 0; ks < 2; ++ks) { const bf16x8 a = lds_b128(lds + HG_KHT + (16 * i + r) * 144 + (32 * ks + 8 * g) * 2), b = lds_b128(lds + HG_VT + (16 * w + r) * 144 + (32 * ks + 8 * g) * 2); s = mfma16(a, b, s); }
        Sacc[i] = s; }
    if (FULL) {
#pragma unroll
        for (int tt = 0; tt < 4; ++tt)
#pragma unroll
            for (int e = 0; e < 4; ++e) { float ss = oacc[tt][e] * oacc[tt][e];
                ss += dpp_f(ss, 0xB1); ss += dpp_f(ss, 0x4E); ss += dpp_f(ss, 0x141); ss += dpp_f(ss, 0x140);
                if (r == 0) *(LAS float*)(lds + HG_P2 + ((16 * tt + 4 * g + e) * 8 + w) * 4) = ss; }
        LDS_WAIT(); __syncthreads();
#pragma unroll
        for (int tt = 0; tt < 4; ++tt)
#pragma unroll
            for (int e = 0; e < 4; ++e) { const int t = 16 * tt + 4 * g + e;
                const f32x4 pa = *(LAS f32x4*)(lds + HG_P2 + t * 32), pb = *(LAS f32x4*)(lds + HG_P2 + t * 32 + 16); const float ss = ((pa[0] + pa[1]) + (pa[2] + pa[3])) + ((pb[0] + pb[1]) + (pb[2] + pb[3]));
                const float v = oacc[tt][e] * (__builtin_amdgcn_rsqf(ss * (1.f / 128.f) + EPS)) * gn;
                *(LAS unsigned short*)(lds + HG_OT + t * 272 + (16 * w + r) * 2) = (unsigned short)(cvt_pk_bf16(v, 0.f) & 0xffffu); }
        LDS_WAIT(); __syncthreads();
        { const int t = tid >> 3;
#pragma unroll
          for (int j = 0; j < 2; ++j) { const int ch = (tid & 7) * 2 + j; const u32x4 q8 = *(LAS u32x4*)(lds + HG_OT + t * 272 + ch * 16);
              u32x2 w8; w8.x = pack4_fp8(bflo(q8.x), bfhi(q8.x), bflo(q8.y), bfhi(q8.y)); w8.y = pack4_fp8(bflo(q8.z), bfhi(q8.z), bflo(q8.w), bfhi(q8.w));
              *(u32x2*)((unsigned char*)A.OR_ + (row0 + t) * 1024 + (size_t)h * 128 + ch * 8) = w8; } }
    } else { LDS_WAIT(); __syncthreads(); }
}
__device__ __forceinline__ void hg_unit_ids(int u, int& b, int& h, int& seg) { b = u >> 6; h = (u >> 3) & 7; seg = u & 7; }
__device__ __forceinline__ void h1_unit(const Frame& F, const HgArgs& A) {
    int b, h, seg; hg_unit_ids(F.vcu, b, h, seg);
    f32x4 Sacc[8];
#pragma unroll
    for (int i = 0; i < 8; ++i) Sacc[i] = (f32x4){0.f, 0.f, 0.f, 0.f};
    float ld0 = 1.f, ld1 = 1.f;
    const size_t rbase = (size_t)b * SEQ + (size_t)(16 * seg) * 64;
    const float lb0 = A.LB[h * 128 + 2 * F.lane], lb1 = A.LB[h * 128 + 2 * F.lane + 1], gn = A.RNG[16 * F.wave + (F.lane & 15)];
    HgRegs Ra, Rb;
    if (seg == 0) { hg_load<false>(Ra, A, (size_t)NTOK, h, F.lane, F.wave); hg_load<false>(Rb, A, rbase, h, F.lane, F.wave); hg_chunk<false>(F.lds, A, Ra, (size_t)NTOK, h, 48, Sacc, ld0, ld1, F.tid, F.lane, F.wave, lb0, lb1, gn); }
    else hg_load<false>(Rb, A, rbase, h, F.lane, F.wave);
    for (int c = 0; c < 16; c += 2) {
        hg_load<false>(Ra, A, rbase + (size_t)(c + 1) * 64, h, F.lane, F.wave);
        hg_chunk<false>(F.lds, A, Rb, rbase + (size_t)c * 64, h, 0, Sacc, ld0, ld1, F.tid, F.lane, F.wave, lb0, lb1, gn);
        hg_load<false>(Rb, A, rbase + (size_t)(c + 2 < 16 ? c + 2 : 15) * 64, h, F.lane, F.wave);
        hg_chunk<false>(F.lds, A, Ra, rbase + (size_t)(c + 1) * 64, h, 0, Sacc, ld0, ld1, F.tid, F.lane, F.wave, lb0, lb1, gn);
    }
    float* sl = A.SLOC + (size_t)F.vcu * 16384 + F.wave * 2048 + F.lane;
#pragma unroll
    for (int i = 0; i < 8; ++i)
#pragma unroll
        for (int e = 0; e < 4; ++e) sl[(i * 4 + e) * 64] = Sacc[i][e];
    if (F.wave == 0) { A.DSEG[F.vcu * 128 + 2 * F.lane] = ld0; A.DSEG[F.vcu * 128 + 2 * F.lane + 1] = ld1; }
}
__device__ __forceinline__ void h3_unit(const Frame& F, const HgArgs& A) {
    int b, h, seg; hg_unit_ids(F.vcu, b, h, seg);
    const int g = F.lane >> 4;
    f32x4 Sacc[8];
#pragma unroll
    for (int i = 0; i < 8; ++i) Sacc[i] = (f32x4){0.f, 0.f, 0.f, 0.f};
    for (int j = 0; j < seg; j += 2) {
        const bool two = j + 1 < seg; const int ua = (F.vcu & ~7) + j, ub = two ? ua + 1 : ua;
        const float* sa = A.SLOC + (size_t)ua * 16384 + F.wave * 2048 + F.lane; const float* da = A.DSEG + ua * 128;
        const float* sb = A.SLOC + (size_t)ub * 16384 + F.wave * 2048 + F.lane; const float* db = A.DSEG + ub * 128;
        f32x4 dda[8], ddb[8]; float la[32], lb[32];
#pragma unroll
        for (int i = 0; i < 8; ++i) { dda[i] = *(const f32x4*)(da + 16 * i + 4 * g); ddb[i] = *(const f32x4*)(db + 16 * i + 4 * g);
#pragma unroll
            for (int e = 0; e < 4; ++e) { la[i * 4 + e] = sa[(i * 4 + e) * 64]; lb[i * 4 + e] = sb[(i * 4 + e) * 64]; } }
#pragma unroll
        for (int i = 0; i < 8; ++i)
#pragma unroll
            for (int e = 0; e < 4; ++e) { const float s1 = Sacc[i][e] * dda[i][e] + la[i * 4 + e]; Sacc[i][e] = two ? s1 * ddb[i][e] + lb[i * 4 + e] : s1; } }
    for (int i = F.tid; i < 64 * 36; i += NWAVES * 64) *(LAS unsigned*)(F.lds + HG_PL + i * 4) = 0u;
    LDS_WAIT(); __syncthreads();
    float ld0 = 1.f, ld1 = 1.f;
    const size_t rbase = (size_t)b * SEQ + (size_t)(16 * seg) * 64;
    const float lb0 = A.LB[h * 128 + 2 * F.lane], lb1 = A.LB[h * 128 + 2 * F.lane + 1], gn = A.RNG[16 * F.wave + (F.lane & 15)];
    HgRegs Ra, Rb;
    if (seg == 0) { hg_load<false>(Ra, A, (size_t)NTOK, h, F.lane, F.wave); hg_load<true>(Rb, A, rbase, h, F.lane, F.wave); hg_chunk<false>(F.lds, A, Ra, (size_t)NTOK, h, 48, Sacc, ld0, ld1, F.tid, F.lane, F.wave, lb0, lb1, gn); }
    else hg_load<true>(Rb, A, rbase, h, F.lane, F.wave);
    for (int c = 0; c < 16; c += 2) {
        hg_load<true>(Ra, A, rbase + (size_t)(c + 1) * 64, h, F.lane, F.wave);
        hg_chunk<true>(F.lds, A, Rb, rbase + (size_t)c * 64, h, 0, Sacc, ld0, ld1, F.tid, F.lane, F.wave, lb0, lb1, gn);
        hg_load<true>(Rb, A, rbase + (size_t)(c + 2 < 16 ? c + 2 : 15) * 64, h, F.lane, F.wave);
        hg_chunk<true>(F.lds, A, Ra, rbase + (size_t)(c + 1) * 64, h, 0, Sacc, ld0, ld1, F.tid, F.lane, F.wave, lb0, lb1, gn);
    }
}

struct KnArgs { const bf16_t *AK, *AV; const float *GK, *GQ; unsigned char *KN, *VV; };
__device__ __forceinline__ void knorm_share(const Frame& F, const KnArgs& A) {
    const int gw = F.vcu * NWAVES + F.wave, NGW = F.G * NWAVES, sub = F.lane >> 4, part = F.lane & 15;
    const f32x4 g0 = *(const f32x4*)(A.GK + 8 * part) * *(const f32x4*)(A.GQ + 8 * part), g1 = *(const f32x4*)(A.GK + 8 * part + 4) * *(const f32x4*)(A.GQ + 8 * part + 4);
    constexpr int KB = 4;
    for (int vb0 = gw * 4; vb0 < NB * 2 * NKEY; vb0 += KB * NGW * 4) {
        u32x4 kk[KB], vv[KB];
#pragma unroll
        for (int q = 0; q < KB; ++q) { const int v0 = vb0 + q * NGW * 4; const int v = (v0 < NB * 2 * NKEY ? v0 : vb0) + sub;
            const int b = v / (2 * NKEY), rem = v % (2 * NKEY), kvh = rem / NKEY, j = rem % NKEY;
            const size_t srow = j < 16 ? (size_t)(META_ROW0 + j) : (size_t)b * SEQ + (j - 16);
            kk[q] = *(const u32x4*)(A.AK + srow * 256 + kvh * 128 + 8 * part); vv[q] = *(const u32x4*)(A.AV + srow * 256 + kvh * 128 + 8 * part); }
#pragma unroll
        for (int q = 0; q < KB; ++q) { const int v0 = vb0 + q * NGW * 4; if (v0 >= NB * 2 * NKEY) continue;
            const int v = v0 + sub;
            const float x0 = bflo(kk[q].x), x1 = bfhi(kk[q].x), x2 = bflo(kk[q].y), x3 = bfhi(kk[q].y), x4 = bflo(kk[q].z), x5 = bfhi(kk[q].z), x6 = bflo(kk[q].w), x7 = bfhi(kk[q].w);
            float ss = ((x0 * x0 + x1 * x1) + (x2 * x2 + x3 * x3)) + ((x4 * x4 + x5 * x5) + (x6 * x6 + x7 * x7));
            ss += __shfl_xor(ss, 1); ss += __shfl_xor(ss, 2); ss += __shfl_xor(ss, 4); ss += __shfl_xor(ss, 8);
            const float rstd = __builtin_amdgcn_rsqf(ss * (1.f / 128.f) + EPS);
            int k0 = __builtin_amdgcn_cvt_pk_fp8_f32(x0 * rstd * g0[0], x1 * rstd * g0[1], 0, false); k0 = __builtin_amdgcn_cvt_pk_fp8_f32(x2 * rstd * g0[2], x3 * rstd * g0[3], k0, true);
            int k1 = __builtin_amdgcn_cvt_pk_fp8_f32(x4 * rstd * g1[0], x5 * rstd * g1[1], 0, false); k1 = __builtin_amdgcn_cvt_pk_fp8_f32(x6 * rstd * g1[2], x7 * rstd * g1[3], k1, true);
            int w0 = __builtin_amdgcn_cvt_pk_fp8_f32(bflo(vv[q].x), bfhi(vv[q].x), 0, false); w0 = __builtin_amdgcn_cvt_pk_fp8_f32(bflo(vv[q].y), bfhi(vv[q].y), w0, true);
            int w1 = __builtin_amdgcn_cvt_pk_fp8_f32(bflo(vv[q].z), bfhi(vv[q].z), 0, false); w1 = __builtin_amdgcn_cvt_pk_fp8_f32(bflo(vv[q].w), bfhi(vv[q].w), w1, true);
            *(u32x2*)(A.KN + (size_t)v * 128 + 8 * part) = (u32x2){(unsigned)k0, (unsigned)k1};
            { unsigned char* vr = A.VV + (size_t)v * 128 + 32 * (part >> 2) + 4 * (part & 3); *(unsigned*)vr = (unsigned)w0; *(unsigned*)(vr + 16) = (unsigned)w1; } }
    }
}

constexpr int IX_HIST = 0, IX_CAND = 8192, CB_CAP = 704, IX_QB = CB_CAP * 6, IX_END = IX_CAND + 8 * 4 * IX_QB;
struct IxArgs { const bf16_t *IQ, *IKC; const float* IW; unsigned short* IDX; int* CNT; };

__device__ __forceinline__ unsigned sortable_key(unsigned bits) { return bits ^ ((bits >> 31) ? 0xffffffffu : 0x80000000u); }
__device__ __forceinline__ float key_to_float(unsigned k) { return __uint_as_float((k & 0x80000000u) ? (k ^ 0x80000000u) : ~k); }
__device__ __forceinline__ float vmax0(float a) { float r; asm("v_max_f32_e32 %0, 0, %1" : "=v"(r) : "v"(a)); return r; }
__device__ __forceinline__ float vfma(float a, float b, float c) { float r; asm("v_fma_f32 %0, %1, %2, %3" : "=v"(r) : "v"(a), "v"(b), "v"(c)); return r; }

__device__ __forceinline__ void radix_scan(LAS unsigned* hist, int lane, unsigned need, unsigned& bin, unsigned& above, unsigned& cbin) {
    const u32x4 c = *(LAS u32x4*)(hist + 4 * lane);
    const unsigned tot = c.x + c.y + c.z + c.w; unsigned inc = tot;
    inc += (unsigned)__builtin_amdgcn_update_dpp(0, (int)inc, 0x111, 0xf, 0xf, false);
    inc += (unsigned)__builtin_amdgcn_update_dpp(0, (int)inc, 0x112, 0xf, 0xf, false);
    inc += (unsigned)__builtin_amdgcn_update_dpp(0, (int)inc, 0x114, 0xf, 0xf, false);
    inc += (unsigned)__builtin_amdgcn_update_dpp(0, (int)inc, 0x118, 0xf, 0xf, false);
    { const unsigned t0 = (unsigned)__builtin_amdgcn_readlane((int)inc, 15), t1 = (unsigned)__builtin_amdgcn_readlane((int)inc, 31), t2 = (unsigned)__builtin_amdgcn_readlane((int)inc, 47);
      const int row = lane >> 4; inc += (row >= 1 ? t0 : 0u) + (row >= 2 ? t1 : 0u) + (row >= 3 ? t2 : 0u); }
    const unsigned total = (unsigned)__builtin_amdgcn_readlane((int)inc, 63);
    const unsigned a3 = total - inc, a2 = a3 + c.w, a1 = a2 + c.z, a0 = a1 + c.y;
    int fb = -1; unsigned fa = 0, fc = 0;
    if (a3 < need && need <= a3 + c.w) { fb = 4 * lane + 3; fa = a3; fc = c.w; }
    else if (a2 < need && need <= a2 + c.z) { fb = 4 * lane + 2; fa = a2; fc = c.z; }
    else if (a1 < need && need <= a1 + c.y) { fb = 4 * lane + 1; fa = a1; fc = c.y; }
    else if (a0 < need && need <= a0 + c.x) { fb = 4 * lane; fa = a0; fc = c.x; }
    const unsigned long long bm = __ballot(fb >= 0);
    const int src = bm ? __builtin_ctzll(bm) : 0;
    bin = (unsigned)__builtin_amdgcn_readlane(fb, src); above = (unsigned)__builtin_amdgcn_readlane((int)fa, src); cbin = (unsigned)__builtin_amdgcn_readlane((int)fc, src);
}
template <int NE = CB_CAP / 64>
__device__ __forceinline__ float topk_select(LAS unsigned char* qb, int n, LAS unsigned* hist, int lane, unsigned short* idx_out, int& kept, unsigned need0 = 256u) {
    asm volatile("" ::: "memory");
    unsigned key[NE], ix[NE]; unsigned vmask = 0;
#pragma unroll
    for (int i = 0; i < NE; ++i) { const int e = lane + 64 * i;
        key[i] = sortable_key(*(LAS unsigned*)(qb + 4 * e)); ix[i] = *(LAS unsigned short*)(qb + 4 * CB_CAP + 2 * e); vmask |= e < n ? 1u << i : 0u; }
    unsigned kmask = 0, kval = 0, need = need0; int pass0 = 0;
    { const unsigned d0 = (unsigned)__builtin_amdgcn_readfirstlane((int)(key[0] >> 24)); bool diff = false;
#pragma unroll
      for (int i = 0; i < NE; ++i) diff |= ((vmask >> i) & 1u) && (key[i] >> 24) != d0;
      if (__ballot(diff) == 0ull) { kval = d0 << 24; kmask = 0xff000000u; pass0 = 1; } }
    const int npass = idx_out ? 3 : 2;
    unsigned above_tot = 0; bool whole = false;
#pragma unroll 1
    for (int pass = pass0; pass < npass; ++pass) { const int shift = 24 - 8 * pass;
        *(LAS u32x4*)(hist + 4 * lane) = (u32x4){0u, 0u, 0u, 0u};
        if (pass == 0) {
            const unsigned d0 = key[0] >> 24; unsigned c0 = 0;
#pragma unroll
            for (int i = 0; i < NE; ++i) if ((vmask >> i) & 1u) { const unsigned d = key[i] >> 24; if (d == d0) ++c0; else __hip_atomic_fetch_add(hist + d, 1u, __ATOMIC_RELAXED, __HIP_MEMORY_SCOPE_WORKGROUP); }
            if (vmask & 1u) __hip_atomic_fetch_add(hist + d0, c0, __ATOMIC_RELAXED, __HIP_MEMORY_SCOPE_WORKGROUP);
        } else {
#pragma unroll
            for (int i = 0; i < NE; ++i) if (((vmask >> i) & 1u) && (key[i] & kmask) == kval) __hip_atomic_fetch_add(hist + ((key[i] >> shift) & 255u), 1u, __ATOMIC_RELAXED, __HIP_MEMORY_SCOPE_WORKGROUP);
        }
        LDS_WAIT();
        unsigned bin, above, cbin; radix_scan(hist, lane, need, bin, above, cbin);
        kval |= bin << shift; kmask |= 255u << shift; need -= above; above_tot += above;
        if (cbin == need) { whole = true; break; }
        if (pass == npass - 1 && !idx_out) { if (above_tot + cbin <= CB_CAP - 192) { need = cbin; whole = true; } }
    }
    unsigned base = 0, bbin = 0;
    if (whole) {
#pragma unroll
        for (int i = 0; i < NE; ++i) { const bool sel = ((vmask >> i) & 1u) && (key[i] & kmask) >= kval;
            const unsigned long long bm = __ballot(sel);
            const unsigned pos = base + __builtin_amdgcn_mbcnt_hi((unsigned)(bm >> 32), __builtin_amdgcn_mbcnt_lo((unsigned)bm, 0u));
            if (sel && (pos < 256 || !idx_out)) {
                if (idx_out) idx_out[pos] = (unsigned short)ix[i];
                else { const unsigned kk = key[i]; *(LAS unsigned*)(qb + 4 * pos) = (kk & 0x80000000u) ? (kk ^ 0x80000000u) : ~kk; *(LAS unsigned short*)(qb + 4 * CB_CAP + 2 * pos) = (unsigned short)ix[i]; } }
            base += (unsigned)__builtin_popcountll(bm); }
    } else
#pragma unroll
    for (int i = 0; i < NE; ++i) { const unsigned km = key[i] & kmask; const bool v = (vmask >> i) & 1u;
        const bool inb = v && km == kval;
        const unsigned long long bi = __ballot(inb);
        const unsigned rk = bbin + __builtin_amdgcn_mbcnt_hi((unsigned)(bi >> 32), __builtin_amdgcn_mbcnt_lo((unsigned)bi, 0u));
        bbin += (unsigned)__builtin_popcountll(bi);
        const bool sel = (v && km > kval) || (inb && rk < need);
        const unsigned long long bm = __ballot(sel);
        const unsigned pos = base + __builtin_amdgcn_mbcnt_hi((unsigned)(bm >> 32), __builtin_amdgcn_mbcnt_lo((unsigned)bm, 0u));
        if (sel && (pos < 256 || !idx_out)) {
            if (idx_out) idx_out[pos] = (unsigned short)ix[i];
            else { const unsigned kk = key[i]; *(LAS unsigned*)(qb + 4 * pos) = (kk & 0x80000000u) ? (kk ^ 0x80000000u) : ~kk; *(LAS unsigned short*)(qb + 4 * CB_CAP + 2 * pos) = (unsigned short)ix[i]; } }
        base += (unsigned)__builtin_popcountll(bm); }
    LDS_WAIT();
    kept = (int)base;
    return key_to_float(kval);
}

typedef float f32x16 __attribute__((ext_vector_type(16)));
__device__ __forceinline__ void ix_bload(const bf16_t* sub, int lane, bf16x8 (&bf)[4]) {
#pragma unroll
    for (int ks = 0; ks < 4; ++ks) bf[ks] = *(const bf16x8*)(sub + (ks * 64 + lane) * 8);
}
__device__ __forceinline__ f32x16 ix_mma(const bf16x8 (&af)[4], const bf16x8 (&bf)[4]) {
    f32x16 acc = {};
#pragma unroll
    for (int ks = 0; ks < 4; ++ks) acc = __builtin_amdgcn_mfma_f32_32x32x16_bf16(af[ks], bf[ks], acc, 0, 0, 0);
    return acc;
}
__device__ __forceinline__ void ix_unit(const Frame& F, const IxArgs& A, int b, int qg) {
    const int lane = F.lane, w = F.wave, rho = lane & 31, hf = lane >> 5;
    const int t0 = 32 * qg + 4 * w;
    const int qq = 2 * ((rho >> 2) & 1) + (rho >> 4), hh = 4 * ((rho >> 3) & 1) + (rho & 3);
    bf16x8 af[4];
    { const bf16_t* p = A.IQ + ((size_t)b * SEQ + t0 + qq) * 512 + hh * 64 + 8 * hf;
#pragma unroll
      for (int ks = 0; ks < 4; ++ks) af[ks] = *(const bf16x8*)(p + 16 * ks); }
    float wv[2][8];
#pragma unroll
    for (int a = 0; a < 2; ++a) { const float* p = A.IW + ((size_t)b * SEQ + t0 + 2 * hf + a) * 8; const f32x4 x = *(const f32x4*)p, y = *(const f32x4*)(p + 4);
        wv[a][0] = x[0]; wv[a][1] = x[1]; wv[a][2] = x[2]; wv[a][3] = x[3]; wv[a][4] = y[0]; wv[a][5] = y[1]; wv[a][6] = y[2]; wv[a][7] = y[3]; }
    float tau0 = -INFINITY, tau1 = -INFINITY; int cnt0 = 0, cnt1 = 0; bool est = true;
    const int lim0 = 16 + t0 + 2 * hf, lim1 = lim0 + 1;
    const int nsub = ((16 + t0 + 3) >> 5) + 1;
    LAS unsigned char* candw = F.lds + IX_CAND + w * 4 * IX_QB;
    LAS unsigned char* cb0 = candw + (2 * hf) * IX_QB; LAS unsigned char* cb1 = cb0 + IX_QB;
    LAS unsigned* hist = (LAS unsigned*)(F.lds + IX_HIST + w * 1024);
    const bf16_t* ikc_b = A.IKC + (size_t)b * IKC_SUBS * 2048;
#define IX_PROCESS(cur, k_) do { \
        float sc0 = 0.f, sc1 = 0.f; \
        _Pragma("unroll") for (int c = 0; c < 8; ++c) { sc0 = vfma(vmax0(cur[c]), wv[0][c], sc0); sc1 = vfma(vmax0(cur[8 + c]), wv[1][c], sc1); } \
        const int j = 32 * (k_) + rho; \
        const bool p0 = (sc0 > tau0) && (j <= lim0), p1 = (sc1 > tau1) && (j <= lim1); \
        const unsigned long long m0 = __ballot(p0), m1 = __ballot(p1); \
        if ((m0 | m1) != 0ull) { \
            const unsigned lm = (1u << rho) - 1u; \
            { const unsigned mine = hf ? (unsigned)(m0 >> 32) : (unsigned)m0; const int pos = cnt0 + __popc(mine & lm); \
              if (p0) { *(LAS unsigned*)(cb0 + 4 * pos) = __float_as_uint(sc0); *(LAS unsigned short*)(cb0 + 4 * CB_CAP + 2 * pos) = (unsigned short)j; } cnt0 += __popc(mine); } \
            { const unsigned mine = hf ? (unsigned)(m1 >> 32) : (unsigned)m1; const int pos = cnt1 + __popc(mine & lm); \
              if (p1) { *(LAS unsigned*)(cb1 + 4 * pos) = __float_as_uint(sc1); *(LAS unsigned short*)(cb1 + 4 * CB_CAP + 2 * pos) = (unsigned short)j; } cnt1 += __popc(mine); } \
              \
            if (__ballot(cnt0 > CB_CAP - 32 || cnt1 > CB_CAP - 32) != 0ull) { \
                _Pragma("unroll 1") for (int q = 0; q < 4; ++q) { const int qc = __builtin_amdgcn_readlane((q & 1) ? cnt1 : cnt0, (q >> 1) * 32); \
                    if (qc > CB_CAP - 32) { int kept_; unsigned need_ = 256u; \
                        if (est && __builtin_amdgcn_readlane(__float_as_int((q & 1) ? tau1 : tau0), (q >> 1) * 32) == (int)0xff800000) {     \
                            const unsigned r_ = (unsigned)((512 * qc) / (17 + t0 + q)) + 1u; need_ = r_ < 256u ? (r_ < 24u ? 24u : r_) : 256u; } \
                        const float nt = topk_select(candw + q * IX_QB, qc, hist, lane, nullptr, kept_, need_); \
                        if (hf == (q >> 1)) { if (q & 1) { tau1 = nt; cnt1 = kept_; } else { tau0 = nt; cnt0 = kept_; } } } } } \
        } } while (0)
#pragma unroll 1
    for (int attempt = 0; attempt < 2; ++attempt) {
    tau0 = -INFINITY; tau1 = -INFINITY; cnt0 = 0; cnt1 = 0;
    bf16x8 bA[4], bB[4]; f32x16 accA, accB;
    const unsigned char* ikc_l = (const unsigned char*)ikc_b + 16 * lane; const int slast = nsub - 1;
    ix_bload(ikc_b, lane, bA); ix_bload(ikc_b + (size_t)(slast < 1 ? slast : 1) * 2048, lane, bB);
    accA = ix_mma(af, bA); accB = ix_mma(af, bB);
    asm volatile("s_nop 15\n\ts_nop 7" : "+v"(accA), "+v"(accB));
#define IX_GLD4(B, sidx) do { const unsigned char* p_ = ikc_l + (size_t)((sidx) < slast ? (sidx) : slast) * 4096; \
        asm volatile("global_load_dwordx4 %0, %4, off\n\tglobal_load_dwordx4 %1, %4, off offset:1024\n\tglobal_load_dwordx4 %2, %4, off offset:2048\n\tglobal_load_dwordx4 %3, %4, off offset:3072" \
                     : "=&v"(B[0]), "=&v"(B[1]), "=&v"(B[2]), "=&v"(B[3]) : "v"(p_) : "memory"); } while (0)
#pragma unroll 1
    for (int k = 0; k < nsub; k += 2) {
        bf16x8 nA[4], nB[4];
        IX_GLD4(nA, k + 2); IX_GLD4(nB, k + 3);
        IX_PROCESS(accA, k);
        if (k + 1 < nsub) IX_PROCESS(accB, k + 1);
        asm volatile("s_waitcnt vmcnt(0)" : "+v"(nA[0]), "+v"(nA[1]), "+v"(nA[2]), "+v"(nA[3]), "+v"(nB[0]), "+v"(nB[1]), "+v"(nB[2]), "+v"(nB[3]) :: "memory");
        accA = ix_mma(af, nA); accB = ix_mma(af, nB);
        asm volatile("s_nop 15\n\ts_nop 7" : "+v"(accA), "+v"(accB));
    }
    { int short_ = 0;
#pragma unroll
      for (int q = 0; q < 4; ++q) { const int n_ = __builtin_amdgcn_readlane((q & 1) ? cnt1 : cnt0, (q >> 1) * 32), nt_ = 17 + t0 + q; short_ |= (n_ < (nt_ < 256 ? nt_ : 256)) ? 1 : 0; }
      if (!short_) break;
      est = false; }
    }
#undef IX_GLD4
#undef IX_PROCESS
#pragma unroll 1
    for (int q = 0; q < 4; ++q) { const size_t row = (size_t)b * SEQ + t0 + q; unsigned short* io = A.IDX + row * 256; const int n = __builtin_amdgcn_readlane((q & 1) ? cnt1 : cnt0, (q >> 1) * 32);
        LAS unsigned char* qb = candw + q * IX_QB;
        if (n > 256) { int k_; if (n <= 576) (void)topk_select<9>(qb, n, hist, lane, io, k_); else (void)topk_select<CB_CAP / 64>(qb, n, hist, lane, io, k_); if (lane == 0) A.CNT[row] = 256; }
        else {
#pragma unroll
            for (int i = 0; i < 4; ++i) { const int e = lane + 64 * i; io[e] = e < n ? *(LAS unsigned short*)(qb + 4 * CB_CAP + 2 * e) : (unsigned short)0; }
            if (lane == 0) A.CNT[row] = n; } }
    LDS_WAIT();
}

constexpr int AT_VB = 0, AT_IDX = 131072, AT_END = 131072 + 8 * 512;
static_assert(AT_END <= LDSCTL_OFF && IX_END <= LDSCTL_OFF, "LDS maps");
struct AtArgs { const bf16_t* AQ; const unsigned char *KN, *VV; bf16_t* OA; const unsigned short* IDX; const int* CNT; const float* GQ; bf16_t* DUMMY; };
typedef __bf16 bf16x2_t __attribute__((ext_vector_type(2)));
__device__ __forceinline__ bf16x8 fp8x8_to_bf16(unsigned d0, unsigned d1) {
    u32x4 o; o.x = __builtin_bit_cast(unsigned, __builtin_amdgcn_cvt_scalef32_pk_bf16_fp8(d0, 1.0f, false)); o.y = __builtin_bit_cast(unsigned, __builtin_amdgcn_cvt_scalef32_pk_bf16_fp8(d0, 1.0f, true));
    o.z = __builtin_bit_cast(unsigned, __builtin_amdgcn_cvt_scalef32_pk_bf16_fp8(d1, 1.0f, false)); o.w = __builtin_bit_cast(unsigned, __builtin_amdgcn_cvt_scalef32_pk_bf16_fp8(d1, 1.0f, true));
    return __builtin_bit_cast(bf16x8, o);
}
__device__ __forceinline__ int vswz(int rho) { return ((rho & 3) | (((rho >> 3) & 1) << 2)) << 1; }
__device__ __forceinline__ s16x4 tr_read(LAS unsigned char* p) { typedef short v4i16 __attribute__((ext_vector_type(4))); return __builtin_bit_cast(s16x4, __builtin_amdgcn_ds_read_tr16_b64_v4i16((LAS v4i16*)p)); }

struct AtPre { u32x2 idxv; int n; u32x4 qraw[2]; };
__device__ __forceinline__ void at_preload(AtPre& P, const AtArgs& A, int b, int kvh, int t, int lane) {
    const size_t row = (size_t)b * SEQ + t; const int g = lane >> 4, hd = lane & 3;
    P.n = t + 17 < 256 ? t + 17 : 256;
    P.idxv = *(const u32x2*)(A.IDX + row * 256 + 4 * lane);
    const unsigned char* qp = (const unsigned char*)A.AQ + row * 1024 + (size_t)(4 * kvh + hd) * 128 + 32 * g;
    P.qraw[0] = *(const u32x4*)qp; P.qraw[1] = *(const u32x4*)(qp + 16);
}
__device__ __forceinline__ void at_query(const AtArgs& A, const AtPre& P, AtPre& PN, bool has_next, int t_next, int kvh_next, LAS unsigned char* vb, LAS unsigned char* idxl, int b, int kvh, int t, int lane) {
    const int r = lane & 15, g = lane >> 4, hd = lane & 3;
    const size_t row = (size_t)b * SEQ + t;
    const int n = P.n;
    *(LAS u32x2*)(idxl + 8 * lane) = P.idxv;
    if (has_next) at_preload(PN, A, b, kvh_next, t_next, lane);
    long qf[4]; float ssq = 0.f;
    {
#pragma unroll
      for (int h2 = 0; h2 < 2; ++h2) { const u32x4 raw = P.qraw[h2];
#define AT_SSQ(d_) do { const float y0 = __builtin_amdgcn_cvt_f32_fp8((int)(d_), 0), y1 = __builtin_amdgcn_cvt_f32_fp8((int)(d_), 1), y2 = __builtin_amdgcn_cvt_f32_fp8((int)(d_), 2), y3 = __builtin_amdgcn_cvt_f32_fp8((int)(d_), 3); \
              ssq += (y0 * y0 + y1 * y1) + (y2 * y2 + y3 * y3); } while (0)
          AT_SSQ(raw.x); AT_SSQ(raw.y); AT_SSQ(raw.z); AT_SSQ(raw.w);
#undef AT_SSQ
          qf[2 * h2] = (long)(((unsigned long long)raw.y << 32) | raw.x); qf[2 * h2 + 1] = (long)(((unsigned long long)raw.w << 32) | raw.z); } }
    ssq += __shfl_xor(ssq, 16); ssq += __shfl_xor(ssq, 32);
    const float qs = (__builtin_amdgcn_rsqf(ssq * (1.f / 128.f) + EPS)) * (0.08838834764831845f * LOG2E);
    const float slope2 = __builtin_amdgcn_exp2f(-(float)(4 * kvh + hd + 1)) * LOG2E;
    const unsigned char* vbase = A.VV + (size_t)(b * 2 + kvh) * NKEY * 128;
    LDS_WAIT();
    f32x4 sc[16];
    unsigned idx_r = (unsigned)(uintptr_t)idxl + 2 * r, idx_g = (unsigned)(uintptr_t)idxl + 8 * g;
    asm volatile("" : "+v"(idx_r), "+v"(idx_g));
    {
        u32x4 kr[8][2];
        const int krl = lane >> 3, kch = lane & 7;
        unsigned idx_k = (unsigned)(uintptr_t)idxl + 4 * krl; asm volatile("" : "+v"(idx_k));
        const unsigned char* kb0 = A.KN + (size_t)(b * 2 + kvh) * NKEY * 128;
        const unsigned kco = 16u * kch;
        unsigned kw0 = (unsigned)(uintptr_t)vb + 8192 + (2 * krl) * 128 + 16 * (kch ^ krl);
        unsigned kw1 = kw0 + 128;
        unsigned kr0 = (unsigned)(uintptr_t)vb + 8192 + r * 128 + 16 * ((2 * g) ^ ((r >> 1) & 7));
        asm volatile("" : "+v"(kw0), "+v"(kw1), "+v"(kr0));
#define AT_KLOAD(dst, i) do { const unsigned iab_ = *(LAS unsigned*)(uintptr_t)(idx_k + 32 * (i)), ia_ = iab_ & 0xffffu, ib_ = iab_ >> 16; \
            dst[0] = *(const u32x4*)(kb0 + (ia_ * 128u + kco)); dst[1] = *(const u32x4*)(kb0 + (ib_ * 128u + kco)); } while (0)
#define AT_KMMA(i) do { const u32x4 f0_ = *(LAS u32x4*)(uintptr_t)(kr0 + ((i) & 3) * 2048), f1_ = *(LAS u32x4*)(uintptr_t)((kr0 ^ 16) + ((i) & 3) * 2048); f32x4 acc = {0.f, 0.f, 0.f, 0.f}; \
            acc = __builtin_amdgcn_mfma_f32_16x16x32_fp8_fp8((long)(((unsigned long long)f0_.y << 32) | f0_.x), qf[0], acc, 0, 0, 0); \
            acc = __builtin_amdgcn_mfma_f32_16x16x32_fp8_fp8((long)(((unsigned long long)f0_.w << 32) | f0_.z), qf[1], acc, 0, 0, 0); \
            acc = __builtin_amdgcn_mfma_f32_16x16x32_fp8_fp8((long)(((unsigned long long)f1_.y << 32) | f1_.x), qf[2], acc, 0, 0, 0); \
            acc = __builtin_amdgcn_mfma_f32_16x16x32_fp8_fp8((long)(((unsigned long long)f1_.w << 32) | f1_.z), qf[3], acc, 0, 0, 0); sc[i] = acc; } while (0)
#pragma unroll
        for (int i = 0; i < 8; ++i) AT_KLOAD(kr[i], i);
#pragma unroll
        for (int i = 0; i < 16; ++i) {
            *(LAS u32x4*)(uintptr_t)(kw0 + (i & 3) * 2048) = kr[i & 7][0]; *(LAS u32x4*)(uintptr_t)(kw1 + (i & 3) * 2048) = kr[i & 7][1];
            if (i + 8 < 16) AT_KLOAD(kr[i & 7], i + 8);
            if (i >= 1) AT_KMMA(i - 1); }
        AT_KMMA(15);
#undef AT_KLOAD
#undef AT_KMMA
    }
    __builtin_amdgcn_sched_barrier(0);
    const int vrl = lane >> 3, vch = lane & 7;
    u32x4 vd[3][4];
    unsigned idx_v = (unsigned)(uintptr_t)idxl; asm volatile("" : "+v"(idx_v));
    unsigned vsl[4];
#pragma unroll
    for (int c4 = 0; c4 < 4; ++c4) { const int rho = 8 * c4 + vrl; vsl[c4] = 2u * (unsigned)(16 * ((rho & 7) >> 2) + 4 * (rho >> 3) + (rho & 3)); }
#define AT_VLOAD(dst, kk) do { _Pragma("unroll") for (int c4 = 0; c4 < 4; ++c4) { const unsigned iv_ = *(LAS unsigned short*)(uintptr_t)(idx_v + 64 * (kk) + vsl[c4]); \
        dst[c4] = *(const u32x4*)(vbase + (iv_ * 128u + 16u * vch)); } } while (0)
    AT_VLOAD(vd[0], 7); AT_VLOAD(vd[1], 6); AT_VLOAD(vd[2], 5);
    const int rep = (lane >> 2) & 3;
    float mx = -INFINITY; const float qpos = (float)(16 + t); int nrel = n - 4 * g - 16 * rep; asm volatile("" : "+v"(nrel));
    unsigned idx_gr = idx_g + 32 * rep; asm volatile("" : "+v"(idx_gr));
    float yv[4][4]; const float c0 = -slope2 * qpos;
    { const bool m1 = rep == 1, m2 = rep == 2, m3 = rep == 3;
#define AT_SM1(MASK) do { _Pragma("unroll") for (int j = 0; j < 4; ++j) { const u32x2 iv = *(LAS u32x2*)(uintptr_t)(idx_gr + 128 * j); \
        float s0 = sc[4 * j][0], s1 = sc[4 * j][1], s2 = sc[4 * j][2], s3 = sc[4 * j][3]; \
        s0 = m1 ? sc[4 * j + 1][0] : s0; s1 = m1 ? sc[4 * j + 1][1] : s1; s2 = m1 ? sc[4 * j + 1][2] : s2; s3 = m1 ? sc[4 * j + 1][3] : s3; \
        s0 = m2 ? sc[4 * j + 2][0] : s0; s1 = m2 ? sc[4 * j + 2][1] : s1; s2 = m2 ? sc[4 * j + 2][2] : s2; s3 = m2 ? sc[4 * j + 2][3] : s3; \
        s0 = m3 ? sc[4 * j + 3][0] : s0; s1 = m3 ? sc[4 * j + 3][1] : s1; s2 = m3 ? sc[4 * j + 3][2] : s2; s3 = m3 ? sc[4 * j + 3][3] : s3; \
        float y0 = fmaf(s0, qs, fmaf((float)(iv.x & 0xffffu), slope2, c0)), y1 = fmaf(s1, qs, fmaf((float)(iv.x >> 16), slope2, c0)), \
              y2 = fmaf(s2, qs, fmaf((float)(iv.y & 0xffffu), slope2, c0)), y3 = fmaf(s3, qs, fmaf((float)(iv.y >> 16), slope2, c0));     \
        if (MASK) { y0 = 64 * j + 0 < nrel ? y0 : -INFINITY; y1 = 64 * j + 1 < nrel ? y1 : -INFINITY; y2 = 64 * j + 2 < nrel ? y2 : -INFINITY; y3 = 64 * j + 3 < nrel ? y3 : -INFINITY; } \
        yv[j][0] = y0; yv[j][1] = y1; yv[j][2] = y2; yv[j][3] = y3; mx = fmaxf(fmaxf(fmaxf(y0, y1), fmaxf(y2, y3)), mx); } } while (0)
      if (n >= 256) AT_SM1(false); else AT_SM1(true);
#undef AT_SM1
    }
    mx = fmaxf(mx, dpp_f(mx, 0x128)); mx = fmaxf(mx, dpp_f(mx, 0x124));
    mx = fmaxf(mx, __shfl_xor(mx, 16)); mx = fmaxf(mx, __shfl_xor(mx, 32));
    float l = 0.f; unsigned pd[4]; const float mxs = mx - 8.f;
#pragma unroll
    for (int j = 0; j < 4; ++j) {
        const float p0 = __builtin_amdgcn_exp2f(yv[j][0] - mxs), p1 = __builtin_amdgcn_exp2f(yv[j][1] - mxs), p2 = __builtin_amdgcn_exp2f(yv[j][2] - mxs), p3 = __builtin_amdgcn_exp2f(yv[j][3] - mxs);
        l += (p0 + p1) + (p2 + p3);
        pd[j] = pack4_fp8(p0, p1, p2, p3); }
    l += dpp_f(l, 0x128); l += dpp_f(l, 0x124);
    l += __shfl_xor(l, 16); l += __shfl_xor(l, 32);
    long pf[8];
#pragma unroll
    for (int j = 0; j < 4; ++j) {
        const unsigned t1 = (unsigned)__builtin_amdgcn_update_dpp(0, (int)pd[j], 0x104, 0xf, 0xf, true), t2 = (unsigned)__builtin_amdgcn_update_dpp(0, (int)pd[j], 0x108, 0xf, 0xf, true),
                       t3 = (unsigned)__builtin_amdgcn_update_dpp(0, (int)pd[j], 0x10C, 0xf, 0xf, true);
        pf[2 * j] = (long)(((unsigned long long)t1 << 32) | pd[j]); pf[2 * j + 1] = (long)(((unsigned long long)t3 << 32) | t2); }
    f32x4 oa[8];
#pragma unroll
    for (int m = 0; m < 8; ++m) oa[m] = (f32x4){0.f, 0.f, 0.f, 0.f};
    const int trow = 8 * g + ((lane & 15) >> 1);
    const unsigned tr0 = (unsigned)(uintptr_t)vb + trow * 128 + 16 * ((trow >> 1) & 7) + 8 * (lane & 1);
    unsigned trm[8];
#pragma unroll
    for (int m = 0; m < 8; ++m) trm[m] = tr0 ^ (16u * m);
    unsigned vw[4];
#pragma unroll
    for (int c4 = 0; c4 < 4; ++c4) { const int rho = 8 * c4 + vrl; vw[c4] = (unsigned)(uintptr_t)vb + rho * 128 + 16 * (vch ^ ((rho >> 1) & 7)); }
    unsigned vm = 0;
#pragma unroll
    for (int kk = 0; kk < 8; ++kk) vm |= (__ballot((lane & 15) < 4 && pf[kk] != 0) != 0ull) ? (1u << kk) : 0u;
#pragma unroll
    for (int s = 0; s < 8; ++s) { const int kk = 7 - s; const bool on = (vm >> kk) & 1u;
        if (on) {
#pragma unroll
            for (int c4 = 0; c4 < 4; ++c4) *(LAS u32x4*)(uintptr_t)(vw[c4] + (s & 1) * 4096) = vd[s % 3][c4]; }
        if (s + 3 < 8 && ((vm >> (kk - 3)) & 1u)) AT_VLOAD(vd[s % 3], kk - 3);
        if (on) {
            typedef int v2i32 __attribute__((ext_vector_type(2)));
            v2i32 tt[8];
#pragma unroll
            for (int m = 0; m < 8; ++m) tt[m] = __builtin_amdgcn_ds_read_tr8_b64_v2i32((LAS v2i32*)(uintptr_t)(trm[m] + (s & 1) * 4096));
            __builtin_amdgcn_sched_barrier(0);
#pragma unroll
            for (int m = 0; m < 8; ++m)
                oa[m] = __builtin_amdgcn_mfma_f32_16x16x32_fp8_fp8((long)(((unsigned long long)(unsigned)tt[m][1] << 32) | (unsigned)tt[m][0]), pf[kk], oa[m], 0, 0, 0); }
    }
#undef AT_VLOAD
    const float inv = fast_rcp(l);
    if (r < 4) { unsigned char* op = (unsigned char*)A.OA + row * 1024 + (size_t)(4 * kvh + r) * 128 + 8 * g;
#pragma unroll
        for (int j = 0; j < 4; ++j) { u32x2 o; o.x = pack4_fp8(oa[2 * j][0] * inv, oa[2 * j][1] * inv, oa[2 * j][2] * inv, oa[2 * j][3] * inv);
            o.y = pack4_fp8(oa[2 * j + 1][0] * inv, oa[2 * j + 1][1] * inv, oa[2 * j + 1][2] * inv, oa[2 * j + 1][3] * inv); *(u32x2*)(op + 32 * j) = o; } }
    LDS_WAIT();
}
__device__ __forceinline__ void at_phase(const Frame& F, const AtArgs& A) {
    const int xg = F.vcu >> 5, b = xg >> 1, j = 32 * (xg & 1) + (F.vcu & 31);
    LAS unsigned char* vb = F.lds + AT_VB + F.wave * 16384; LAS unsigned char* idxl = F.lds + AT_IDX + F.wave * 512;
#ifndef AT_REP
#define AT_REP 1
#endif
#define AT_T(qq) (64 * (64 * ((qq) >> 4) + j) + 8 * F.wave + (((qq) >> 1) & 7))
    for (int rep = AT_REP; rep > 0; --rep) {
        AtArgs A2 = A; if (rep > 1) A2.OA = A.DUMMY;
        AtPre Pa, Pb; at_preload(Pa, A2, b, 0, AT_T(0), F.lane);
        for (int qq = 0; qq < 32; qq += 2) {
            at_query(A2, Pa, Pb, true, AT_T(qq + 1), 1, vb, idxl, b, 0, AT_T(qq), F.lane);
            at_query(A2, Pb, Pa, qq + 2 < 32, AT_T((qq + 2) & 31), 0, vb, idxl, b, 1, AT_T(qq + 1), F.lane); } }
#undef AT_T
}

struct Args { const float* in[11]; float* out; unsigned char* ws; int ph_lo, ph_hi, li, pad; };
__global__ void __launch_bounds__(NWAVES * 64, 2) hyb_fwd(Args args) {
    extern __shared__ __attribute__((aligned(16))) unsigned char lds_raw[];
    Frame F;
    F.lds = (LAS unsigned char*)lds_raw;
    volatile LAS unsigned* MISC = (volatile LAS unsigned*)(F.lds + MISC_OFF);
    F.tid = threadIdx.x; F.lane = F.tid & 63; F.wave = __builtin_amdgcn_readfirstlane(F.tid >> 6);
    F.G = gridDim.x; { const int bx = blockIdx.x; F.vcu = (F.G % 8 == 0) ? (bx % 8) * (F.G / 8) + bx / 8 : bx; }
    unsigned char* ws = args.ws;
    gu32* ctl = (gu32*)(ws + WS_CTL);
    for (int u = F.tid; u < (LDS_BYTES - LDSCTL_OFF) / 4; u += NWAVES * 64) ((LAS unsigned*)(F.lds + LDSCTL_OFF))[u] = 0u;
    __syncthreads();
    const int lo = args.ph_lo, hi = args.ph_hi; const bool multi = (hi - lo) > 1;
    XcdBarrier bar; bar.bar = (unsigned*)(ctl + CW_BAR); bar.x = 0; bar.st = nullptr;
    if (multi) bar = xcd_barrier_post((unsigned*)(ctl + CW_BAR), MISC + 8);
#ifndef PHMASK
#define PHMASK 0x7f
#endif
#define IN(k) (((PHMASK >> (k)) & 1) && lo <= (k) && (k) < hi)
#define GRID_BAR(k) do { if (IN(k) && IN((k) + 1)) xcd_barrier(bar); } while (0)
    const float *x = args.in[0], *meta = args.in[1], *norm_g = args.in[2], *w_in = args.in[3], *lb_logits = args.in[4], *r_norm_g = args.in[5], *q_norm_g = args.in[6], *k_norm_g = args.in[7],
                *w_r = args.in[8], *w_a = args.in[9], *w_out = args.in[10];
    unsigned char *W1A8 = ws + WS_W1A8, *W1B8 = ws + WS_W1B8, *WR8 = ws + WS_WR8, *WA8 = ws + WS_WA8, *WO8 = ws + WS_WO8, *XN8 = ws + WS_XN8, *GR8 = ws + WS_GR8, *GA8 = ws + WS_GA8; bf16_t* W1AI = (bf16_t*)(ws + WS_W1AI);
    bf16_t *XN = (bf16_t*)(ws + WS_XN), *RQ = (bf16_t*)(ws + WS_RQ), *RF = (bf16_t*)(ws + WS_RF), *RV = (bf16_t*)(ws + WS_RV), *AQ = (bf16_t*)(ws + WS_AQ);
    bf16_t *AK = (bf16_t*)(ws + WS_AK), *AV = (bf16_t*)(ws + WS_AV), *IQ = (bf16_t*)(ws + WS_IQ), *IKC = (bf16_t*)(ws + WS_IKC); unsigned char *KN = ws + WS_KN, *VV = ws + WS_VV;
    float *IW = (float*)(ws + WS_IW), *LB = (float*)(ws + WS_LB), *SLOC = (float*)(ws + WS_SLOC), *DSEG = (float*)(ws + WS_DSEG);
    unsigned short* IDX = (unsigned short*)(ws + WS_IDX); int* CNT = (int*)(ws + WS_CNT);

#ifndef DUP
#define DUP -1
#endif
#define PH0() do { const P0Args a{x, meta, norm_g, w_in, lb_logits, w_r, w_a, w_out, W1A8, W1B8, WR8, WA8, WO8, XN8, W1AI, XN, LB}; p0_prologue(F, a); } while (0)
  \
#define PH1() do { { pg8::TileOrder S; S.init(MROWS, N1AI, F.G, (int)blockIdx.x, 1, XN, W1AI, XN, W1AI);     \
          const pg8::EpiP1 E{RQ, RF, RV, AQ, AK, AV, IQ, IKC, IW, 18, 1.f}; \
          pg8::gemm_phase<pg8::EpiP1, pg8::TileOrder, true, true, false>(F.lds, 1024, S, E); } \
        { pg8::TileOrder S; S.init(MROWS, N1A8, F.G, F.G == 256 ? (int)((blockIdx.x + 136u) & 255u) : (int)blockIdx.x, 1, (const bf16_t*)XN8, (const bf16_t*)W1A8, (const bf16_t*)XN8, (const bf16_t*)W1A8);     \
          const pg8::EpiP1 E{RQ, RF, RV, AQ, AK, AV, IQ, IKC, IW, 0, ZSCALE}; \
          pg8::gemm_phase<pg8::EpiP1, pg8::TileOrder, true, true, true>(F.lds, 512, S, E); } } while (0)
#ifndef P2MASK
#define P2MASK 7
#endif
#define PH2(M_) do { \
        if (P2MASK & (M_) & 1) { const HgArgs a{RQ, RF, RV, RQ, LB, r_norm_g, SLOC, DSEG}; for (int rep = H1_REP; rep > 0; --rep) h1_unit(F, a); } \
        if (P2MASK & (M_) & 2) { const KnArgs a{AK, AV, k_norm_g, q_norm_g, KN, VV}; for (int rep = KN_REP; rep > 0; --rep) knorm_share(F, a); } \
        if (P2MASK & (M_) & 4) { const IxArgs a{IQ, IKC, IW, IDX, CNT}; \
          for (int ub4 = 0; ub4 < 4 * IX_REP; ++ub4) { const int ub = (ub4 + (F.wave >> 2)) & 3;     \
            const int v = F.vcu, qg = ub == 0 ? v : ub == 1 ? 255 - v : ub == 2 ? ((v + 128) & 255) : 255 - ((v + 128) & 255); ix_unit(F, a, ub, qg); } } } while (0)
#ifndef P3MASK
#define P3MASK 3
#endif
#ifndef H3_REP
#define H3_REP 1
#endif
#ifndef H1_REP
#define H1_REP 1
#endif
#ifndef KN_REP
#define KN_REP 1
#endif
#ifndef IX_REP
#define IX_REP 1
#endif
#define PH3(M_, ORP, OAP) do { \
        if (P3MASK & (M_) & 1) { for (int rep = H3_REP; rep > 0; --rep) { const HgArgs a{RQ, RF, RV, rep > 1 ? (bf16_t*)args.out : ORP, LB, r_norm_g, SLOC, DSEG}; h3_unit(F, a); } __syncthreads(); } \
        if (P3MASK & (M_) & 2) { const AtArgs a{AQ, KN, VV, OAP, IDX, CNT, q_norm_g, (bf16_t*)args.out}; at_phase(F, a); __syncthreads(); } } while (0)
#define PH4() do { pg8::TileOrder S; S.pend = (IN(3) && IN(4)) ? bar.bar : nullptr; S.init(NTOK, N1B, F.G, (int)blockIdx.x, 1, (const bf16_t*)XN8, (const bf16_t*)W1B8, (const bf16_t*)XN8, (const bf16_t*)W1B8); \
        const pg8::EpiP4 E{ws}; \
        pg8::gemm_phase<pg8::EpiP4, pg8::TileOrder, true, true, true>(F.lds, 512, S, E); } while (0)
#define PH5() do { pg8::TileOrder S; S.init(NTOK, 1024, F.G, (int)blockIdx.x, 2, (const bf16_t*)GR8, (const bf16_t*)WR8, (const bf16_t*)GA8, (const bf16_t*)WA8); \
        const pg8::EpiP5 E{RF, RV, XN8}; \
        pg8::gemm_phase<pg8::EpiP5, pg8::TileOrder, true, true, true>(F.lds, 512, S, E); } while (0)
#define PH6() do { pg8::TileOrder S; S.init(NTOK, 1024, F.G, (int)blockIdx.x, 1, (const bf16_t*)XN8, (const bf16_t*)WO8, (const bf16_t*)XN8, (const bf16_t*)WO8); \
        const pg8::EpiP6 E{x, args.out}; \
        pg8::gemm_phase<pg8::EpiP6, pg8::TileOrder, true, true, true>(F.lds, 512, S, E); } while (0)

    if (IN(0)) { PH0(); }
    GRID_BAR(0);
    if (IN(1)) { PH1(); }
    GRID_BAR(1);
    if (IN(2)) { PH2(3); }
    if (IN(2) && IN(3)) xcd_barrier_arrive(bar);
    if (IN(2)) { PH2(4); }
    if (IN(2) && IN(3)) { xcd_barrier_wait(bar); xcd_barrier_arrive(bar); }
    if (IN(3)) { PH3(1, (bf16_t*)GR8, (bf16_t*)GA8); }
    if (IN(2) && IN(3)) xcd_barrier_wait(bar);
    if (IN(3)) { PH3(2, (bf16_t*)GR8, (bf16_t*)GA8); }
    if (IN(3) && IN(4)) xcd_barrier_arrive(bar);
    if (IN(4)) { PH4(); }
    GRID_BAR(4);
    if (IN(5)) { PH5(); }
    GRID_BAR(5);
    if (IN(6)) { PH6(); }
#undef IN
#undef GRID_BAR
}

extern "C" void kernel_launch(void* const* d_in, const int* in_sizes, int n_in, void* d_out, int out_size, void* d_ws, size_t ws_size, hipStream_t stream) {
    static int grid = 0;
    if (grid == 0) {
        if (n_in != 11 || in_sizes[0] != NTOK * DM || out_size != NTOK * DM || ws_size < WS_END) { fprintf(stderr, "kernel_launch: unexpected shapes (n_in %d, in0 %d, out %d, ws %zu); nothing launched\n", n_in, n_in > 0 ? in_sizes[0] : -1, out_size, ws_size); grid = -1; return; }
        int dev = 0, cus = 0, per_cu = 0;
        if (hipGetDevice(&dev) != hipSuccess || hipDeviceGetAttribute(&cus, hipDeviceAttributeMultiprocessorCount, dev) != hipSuccess) { grid = -1; return; }
        if (hipFuncSetAttribute((const void*)hyb_fwd, hipFuncAttributeMaxDynamicSharedMemorySize, LDS_BYTES) != hipSuccess) { fprintf(stderr, "kernel_launch: hipFuncSetAttribute failed\n"); grid = -1; return; }
        if (hipOccupancyMaxActiveBlocksPerMultiprocessor(&per_cu, (const void*)hyb_fwd, NWAVES * 64, LDS_BYTES) != hipSuccess || per_cu < 1) fprintf(stderr, "kernel_launch: occupancy query reports %d\n", per_cu);
        (void)hipGetLastError();
        grid = cus;
        if (grid != 256) fprintf(stderr, "kernel_launch: %d CUs; this kernel's unit maps assume 256\n", grid);
    }
    if (grid < 0) return;
    if (hipMemsetAsync((char*)d_ws + WS_CTL, 0, CTL_ZERO_BYTES, stream) != hipSuccess) return;
    Args a{};
    for (int i = 0; i < 11; ++i) a.in[i] = (const float*)d_in[i];
    a.out = (float*)d_out; a.ws = (unsigned char*)d_ws;
    a.ph_lo = 0; a.ph_hi = 7; a.li = 0;
    hipLaunchKernelGGL(hyb_fwd, dim3(grid), dim3(NWAVES * 64), LDS_BYTES, stream, a);
}
```
